# Optimizing an MI355X kernel written in HIP

```python
import jax, jax.numpy as jnp
from jax import lax
import numpy as np

D_MODEL = 1024
BATCH = 8
SEQ = 2048
DEPTH = 4

MIX_WIDTH = D_MODEL
SGU_CHUNK = 128
SGU_WIDTH = MIX_WIDTH // 2
SGU_GROUPS = 4
SGU_GROUP_DIM = SGU_WIDTH // SGU_GROUPS
ATT_WIDTH = MIX_WIDTH - SGU_WIDTH
ATT_HEAD_DIM = 64
ATT_HEADS = ATT_WIDTH // ATT_HEAD_DIM
IDX_HEADS = 4
IDX_HEAD_DIM = 64
TOPK_MAX = 256
ROPE_THETA = 500000.0
ROPE_FRACTION = 4
D_FF = 2816
Q_BLOCK = 128
RMS_EPS = 1e-6
N_MOD = 9

OFF_SGU_U = 0
OFF_SGU_V = OFF_SGU_U + SGU_WIDTH
OFF_Q = OFF_SGU_V + SGU_WIDTH
OFF_K = OFF_Q + ATT_WIDTH
OFF_V = OFF_K + ATT_WIDTH
OFF_IQ = OFF_V + ATT_WIDTH
OFF_IK = OFF_IQ + IDX_HEADS * IDX_HEAD_DIM
OFF_IW = OFF_IK + IDX_HEAD_DIM
PROJ_WIDTH = OFF_IW + IDX_HEADS

kernel_name = "hymba_gmlp_dsa_macaron_adaln"


def rms_norm(x, g):
    xf = x.astype(jnp.float32)
    y = xf * lax.rsqrt(jnp.mean(xf * xf, axis=-1, keepdims=True) + RMS_EPS)
    return (y * g.astype(jnp.float32)).astype(x.dtype)


def modulate(h, shift, scale):
    return h * (1 + scale[:, None, :]) + shift[:, None, :]


def swiglu(h, w_in, w_out):
    g, u = jnp.split(h @ w_in, 2, axis=-1)
    return (jax.nn.silu(g) * u) @ w_out


def rope_tables(positions, rot_dim):
    inv_freq = ROPE_THETA ** (-jnp.arange(0, rot_dim, 2, dtype=jnp.float32) / rot_dim)
    ang = positions.astype(jnp.float32)[..., None] * inv_freq
    return jnp.cos(ang)[:, :, None, :], jnp.sin(ang)[:, :, None, :]


def partial_rope(x, cos, sin):
    half = cos.shape[-1]
    rot = 2 * half
    xr = x[..., :rot].astype(jnp.float32)
    x1, x2 = xr[..., :half], xr[..., half:]
    out = jnp.concatenate([x1 * cos - x2 * sin, x2 * cos + x1 * sin], axis=-1).astype(x.dtype)
    return jnp.concatenate([out, x[..., rot:]], axis=-1)


def chunked_sgu(u, v, w_s, b_s):
    B, S, _ = u.shape
    n_chunk = S // SGU_CHUNK
    v = v.reshape(B, n_chunk, SGU_CHUNK, SGU_GROUPS, SGU_GROUP_DIM)
    causal = jnp.tril(jnp.ones((SGU_CHUNK, SGU_CHUNK), dtype=bool))
    w = jnp.where(causal[None], w_s, 0).astype(v.dtype)
    mixed = jnp.einsum('gts,bnsgc->bntgc', w, v) + b_s.T[None, None, :, :, None].astype(v.dtype)
    return u * mixed.reshape(B, S, SGU_WIDTH)


def dsa_attention(q, k, v, qi, ki, wi):
    B, S = q.shape[0], q.shape[1]
    top_k = min(TOPK_MAX, S // 4)
    n_blk = S // Q_BLOCK

    def to_blocks(a):
        return a.reshape((B, n_blk, Q_BLOCK) + a.shape[2:]).swapaxes(0, 1)

    t_blocks = jnp.arange(S, dtype=jnp.int32).reshape(n_blk, Q_BLOCK)
    key_pos = jnp.arange(S, dtype=jnp.int32)
    ki_f = ki.astype(jnp.float32)
    scale = ATT_HEAD_DIM ** -0.5

    def one_block(args):
        qb, qib, wib, tb = args
        logits = jax.nn.relu(jnp.einsum('bqhd,bsd->bqhs', qib.astype(jnp.float32), ki_f))
        score = jnp.einsum('bqh,bqhs->bqs', wib.astype(jnp.float32), logits)
        causal = key_pos[None, :] <= tb[:, None]
        score = jnp.where(causal[None], score, -jnp.inf)
        _, idx = lax.top_k(score, top_k)
        valid = idx <= tb[None, :, None]
        kg = jax.vmap(lambda kb, ib: kb[ib])(k, idx)
        vg = jax.vmap(lambda vb, ib: vb[ib])(v, idx)
        s = jnp.einsum('bqhd,bqkhd->bhqk', qb, kg).astype(jnp.float32) * scale
        s = jnp.where(valid[:, None], s, -jnp.inf)
        p = jax.nn.softmax(s, axis=-1).astype(vg.dtype)
        return jnp.einsum('bhqk,bqkhd->bqhd', p, vg)

    out = lax.map(one_block, (to_blocks(q), to_blocks(qi), to_blocks(wi), t_blocks))
    return out.swapaxes(0, 1).reshape(B, S, ATT_WIDTH)


def token_mix(h, cos, sin, w_in, sgu_w, sgu_b, w_out):
    B, S, _ = h.shape
    p = h @ w_in
    u = jax.nn.gelu(p[..., OFF_SGU_U:OFF_SGU_V], approximate=False)
    va = jax.nn.gelu(p[..., OFF_SGU_V:OFF_Q], approximate=False)
    a_out = chunked_sgu(u, va, sgu_w, sgu_b)
    q = partial_rope(p[..., OFF_Q:OFF_K].reshape(B, S, ATT_HEADS, ATT_HEAD_DIM), cos, sin)
    k = partial_rope(p[..., OFF_K:OFF_V].reshape(B, S, ATT_HEADS, ATT_HEAD_DIM), cos, sin)
    v = p[..., OFF_V:OFF_IQ].reshape(B, S, ATT_HEADS, ATT_HEAD_DIM)
    qi = partial_rope(p[..., OFF_IQ:OFF_IK].reshape(B, S, IDX_HEADS, IDX_HEAD_DIM), cos, sin)
    ki = partial_rope(p[..., OFF_IK:OFF_IW][:, :, None, :], cos, sin)[:, :, 0, :]
    wi = p[..., OFF_IW:PROJ_WIDTH]
    b_out = dsa_attention(q, k, v, qi, ki, wi)
    return jnp.concatenate([a_out, b_out], axis=-1) @ w_out


def setup_inputs(seed: int = 0) -> dict:
    key = jax.random.key(seed)
    ks = jax.random.split(key, 24)
    f32 = jnp.float32
    L, D = DEPTH, D_MODEL

    def nrm(k, shape, scale):
        return jax.random.normal(k, shape, f32) * scale

    x = jax.random.normal(ks[0], (BATCH, SEQ, D), f32)
    c = jax.random.normal(ks[1], (BATCH, D), f32)
    positions = (jnp.arange(SEQ, dtype=jnp.int32)[None, :]
                 + jax.random.randint(ks[2], (BATCH, 1), 0, 4096, dtype=jnp.int32))
    return {
        "x": x,
        "c": c,
        "positions": positions,
        "ada_w": nrm(ks[3], (L, D, N_MOD * D), 0.5 * D ** -0.5),
        "ada_b": nrm(ks[4], (L, N_MOD * D), 0.01),
        "norm_ffn1": 1.0 + nrm(ks[5], (L, D), 0.02),
        "ffn1_w_in": nrm(ks[6], (L, D, 2 * D_FF), D ** -0.5),
        "ffn1_w_out": nrm(ks[7], (L, D_FF, D), D_FF ** -0.5),
        "norm_mix": 1.0 + nrm(ks[8], (L, D), 0.02),
        "mix_w_in": nrm(ks[9], (L, D, PROJ_WIDTH), D ** -0.5),
        "sgu_w": nrm(ks[10], (L, SGU_GROUPS, SGU_CHUNK, SGU_CHUNK), SGU_CHUNK ** -0.5),
        "sgu_b": 1.0 + nrm(ks[11], (L, SGU_GROUPS, SGU_CHUNK), 0.02),
        "mix_w_out": nrm(ks[12], (L, MIX_WIDTH, D), MIX_WIDTH ** -0.5),
        "norm_ffn2": 1.0 + nrm(ks[13], (L, D), 0.02),
        "ffn2_w_in": nrm(ks[14], (L, D, 2 * D_FF), D ** -0.5),
        "ffn2_w_out": nrm(ks[15], (L, D_FF, D), D_FF ** -0.5),
        "final_norm": 1.0 + nrm(ks[16], (D,), 0.02),
    }


def reference(x, c, positions, ada_w, ada_b, norm_ffn1, ffn1_w_in, ffn1_w_out,
              norm_mix, mix_w_in, sgu_w, sgu_b, mix_w_out,
              norm_ffn2, ffn2_w_in, ffn2_w_out, final_norm):
    cos, sin = rope_tables(positions, ATT_HEAD_DIM // ROPE_FRACTION)
    cos, sin = cos.astype(x.dtype), sin.astype(x.dtype)
    c_act = jax.nn.silu(c)
    for l in range(DEPTH):
        mod = c_act @ ada_w[l] + ada_b[l]
        sh1, sc1, g1, sh2, sc2, g2, sh3, sc3, g3 = jnp.split(mod, N_MOD, axis=-1)
        h = modulate(rms_norm(x, norm_ffn1[l]), sh1, sc1)
        x = x + 0.5 * g1[:, None, :] * swiglu(h, ffn1_w_in[l], ffn1_w_out[l])
        h = modulate(rms_norm(x, norm_mix[l]), sh2, sc2)
        x = x + g2[:, None, :] * token_mix(h, cos, sin, mix_w_in[l], sgu_w[l], sgu_b[l], mix_w_out[l])
        h = modulate(rms_norm(x, norm_ffn2[l]), sh3, sc3)
        x = x + 0.5 * g3[:, None, :] * swiglu(h, ffn2_w_in[l], ffn2_w_out[l])
    return rms_norm(x, final_norm)
```

```cpp
#include <hip/hip_runtime.h>
#include <hip/hip_cooperative_groups.h>
#include <cstdio>
#include <cstdint>
namespace cg = cooperative_groups;
#ifndef ATT_TRIVIAL
#define ATT_TRIVIAL 0
#endif
#ifndef ATT_IGNORE_MASK
#define ATT_IGNORE_MASK 0
#endif
namespace pg8 {
#define PG8_LAS __attribute__((address_space(3)))
typedef unsigned short bf16_t;
typedef short bf16x8 __attribute__((ext_vector_type(8)));
typedef float f32x4 __attribute__((ext_vector_type(4)));
typedef unsigned u32x4 __attribute__((ext_vector_type(4)));
constexpr int BM = 256, BK = 64, HALF = 128, HTB = HALF * BK * 2  , STAGE_BYTES = 8 * HTB, NXCD = 8, WGM = 8;

__host__ __device__ __forceinline__ int lds_byte(int r, int c) { const int st = (r >> 4) * 2 + (c >> 5), rr = r & 15, cc = c & 31, ob = rr * 64 + cc * 2; return st * 1024 + (ob ^ (((ob >> 9) & 1) << 5)); }
__host__ __device__ __forceinline__ void stage_rc(int b, int& R, int& C) { const int st = b / 1024, sb = b % 1024, swz = sb ^ (((sb >> 9) & 1) << 5); R = (st >> 1) * 16 + swz / 64; C = (st & 1) * 32 + (swz % 64) / 2; }
__host__ __device__ __forceinline__ int perm32(int rho) { const int n = rho >> 4, i = rho & 15; return 8 * (i >> 2) + 4 * n + (i & 3); }

struct Unit { int pm, pn; };
struct Gemm { const bf16_t* A; const bf16_t* Bt; int M, N, K; };

struct StaticOrder {
    int nM, nN, nwg, G, c;
    __host__ __device__ void init(int M, int N, int G_, int c_) { nM = M / BM; nN = N / BM; nwg = nM * nN; G = G_; c = c_; }
    __host__ __device__ bool next(int i, Unit& u) const {
        const long L = (long)i * G + c; if (L >= nwg) return false;
        int wgid = (int)L; { const int q = nwg / NXCD, r = nwg % NXCD, xcd = wgid % NXCD, off = wgid / NXCD; wgid = (xcd < r ? xcd * (q + 1) : r * (q + 1) + (xcd - r) * q) + off; }
        const int nig = WGM * nN, gid = wgid / nig, fm = gid * WGM, gsz = (nM - fm) < WGM ? (nM - fm) : WGM;
        u.pm = fm + ((wgid % nig) % gsz); u.pn = (wgid % nig) / gsz; return true;
    }
    __device__ __forceinline__ void a_ready(const Unit&) const {}
    __device__ __forceinline__ void done(const Unit&) const {}
};

typedef float f32x2_t __attribute__((ext_vector_type(2))); typedef __bf16 bf16x2_t __attribute__((ext_vector_type(2)));
__device__ __forceinline__ unsigned cvt_pk_bf16(float lo, float hi) { f32x2_t v = {lo, hi}; bf16x2_t b = __builtin_convertvector(v, bf16x2_t); return __builtin_bit_cast(unsigned, b); }
typedef float f32x2 __attribute__((ext_vector_type(2)));
__device__ __forceinline__ f32x2 gelu_pk(f32x2 v) {
    const f32x2 av = __builtin_elementwise_abs(v), d = av * 0.2316418882f + 1.0f;
    f32x2 t; t.x = __builtin_amdgcn_rcpf(d.x); t.y = __builtin_amdgcn_rcpf(d.y);
    f32x2 q = t * 0.5307027145f + (-0.7265760135f); q = q * t + 0.7107068705f; q = q * t + (-0.142248368f); q = q * t + 0.127414796f; q = q * t;
    const f32x2 s = (v * v) * (-0.72134752044f);
    f32x2 e; e.x = __builtin_amdgcn_exp2f(s.x); e.y = __builtin_amdgcn_exp2f(s.y);
    const f32x2 m = v * (q * e), r = v - m;
    f32x2 o; o.x = v.x < 0.f ? m.x : r.x; o.y = v.y < 0.f ? m.y : r.y; return o;
}


constexpr int PROW = 3072;
__device__ __forceinline__ float silu_f(float g) { return g * __builtin_amdgcn_rcpf(1.0f + __builtin_amdgcn_exp2f(-1.4426950408889634f * g)); }
struct EpiSwiGLU {
    static constexpr bool PERM = true, AFTER_DRAIN = false;
    bf16_t* O; int ldc;
    __device__ __forceinline__ void operator()(const f32x4 (&acc)[2][2][4][2], const Unit& u, int wr, int wc, int fr, int fq) const {
        const int row0 = u.pm * BM + wr * 64 + fr, col0 = u.pn * HALF + wc * 32 + 8 * fq;
#pragma unroll
        for (int ai = 0; ai < 2; ++ai)
#pragma unroll
            for (int m = 0; m < 4; ++m) { bf16_t* rowp = O + (size_t)(row0 + ai * HALF + m * 16) * ldc + col0;
                const f32x4 g0 = acc[ai][0][m][0], g1 = acc[ai][0][m][1], u0 = acc[ai][1][m][0], u1 = acc[ai][1][m][1];
                u32x4 w; w.x = cvt_pk_bf16(silu_f(g0[0]) * u0[0], silu_f(g0[1]) * u0[1]); w.y = cvt_pk_bf16(silu_f(g0[2]) * u0[2], silu_f(g0[3]) * u0[3]);
                w.z = cvt_pk_bf16(silu_f(g1[0]) * u1[0], silu_f(g1[1]) * u1[1]); w.w = cvt_pk_bf16(silu_f(g1[2]) * u1[2], silu_f(g1[3]) * u1[3]);
                *(u32x4*)rowp = w; }
    }
};
struct EpiResid {
    static constexpr bool PERM = false, AFTER_DRAIN = false;
    const float* base; float* out; const float* gate; int gpitch; float coef;
    __device__ __forceinline__ void operator()(const f32x4 (&acc)[2][2][4][2], const Unit& u, int wr, int wc, int fr, int fq) const {
        const int row0 = u.pm * BM + wr * 64 + fr, col0 = u.pn * BM + wc * 32 + 4 * fq;
        const float* gp = gate + (size_t)(u.pm >> 3) * gpitch + col0;
        f32x4 gv[2][2];
#pragma unroll
        for (int bj = 0; bj < 2; ++bj)
#pragma unroll
            for (int n = 0; n < 2; ++n) gv[bj][n] = *(const f32x4*)(gp + bj * HALF + n * 16) * coef;
#pragma unroll
        for (int ai = 0; ai < 2; ++ai)
#pragma unroll
            for (int m = 0; m < 4; ++m) { const size_t off = (size_t)(row0 + ai * HALF + m * 16) * 1024 + col0;
#pragma unroll
                for (int bj = 0; bj < 2; ++bj)
#pragma unroll
                    for (int n = 0; n < 2; ++n) *(f32x4*)(out + off + bj * HALF + n * 16) = *(const f32x4*)(base + off + bj * HALF + n * 16) + gv[bj][n] * acc[ai][bj][m][n]; }
    }
};
struct EpiProj {
    static constexpr bool PERM = true, AFTER_DRAIN = false;
    bf16_t* P; float* WI; const float* rope;
    __device__ __forceinline__ void operator()(const f32x4 (&acc)[2][2][4][2], const Unit& u, int wr, int wc, int fr, int fq) const {
        const int pn = u.pn; const int row0 = u.pm * BM + wr * 64 + fr, col0 = pn * BM + wc * 32 + 8 * fq;
        const bool is_gelu = pn < 4, is_rope_tile = (pn >= 4 && pn < 8) || pn == 10 || pn == 11;
        const bool rope_wave = is_rope_tile && ((wc & 1) == 0);
#pragma unroll
        for (int ai = 0; ai < 2; ++ai)
#pragma unroll
            for (int m = 0; m < 4; ++m) { const int row = row0 + ai * HALF + m * 16; bf16_t* rowp = P + (size_t)row * PROW + col0;
                f32x4 cs0, cs1, sn0, sn1;
                if (rope_wave) { const f32x4* rp = (const f32x4*)(rope + (size_t)row * 16); cs0 = rp[0]; cs1 = rp[1]; sn0 = rp[2]; sn1 = rp[3]; }
#pragma unroll
                for (int bj = 0; bj < 2; ++bj) { f32x4 v0 = acc[ai][bj][m][0], v1 = acc[ai][bj][m][1];
                    if (is_gelu) { f32x2 a = gelu_pk((f32x2){v0[0], v0[1]}), b = gelu_pk((f32x2){v0[2], v0[3]}), c = gelu_pk((f32x2){v1[0], v1[1]}), d = gelu_pk((f32x2){v1[2], v1[3]});
                        v0 = (f32x4){a.x, a.y, b.x, b.y}; v1 = (f32x4){c.x, c.y, d.x, d.y}; }
                    if (rope_wave && (pn != 11 || (bj == 0 && wc == 0))) {
                        f32x4 p0, p1;
#pragma unroll
                        for (int j = 0; j < 4; ++j) { p0[j] = __shfl_xor(v0[j], 16); p1[j] = __shfl_xor(v1[j], 16); }
                        if (fq == 0) { v0 = v0 * cs0 - p0 * sn0; v1 = v1 * cs1 - p1 * sn1; }
                        else if (fq == 1) { v0 = v0 * cs0 + p0 * sn0; v1 = v1 * cs1 + p1 * sn1; }
                    }
                    if (pn == 11 && bj == 0 && wc == 2 && fq == 0) *(f32x4*)(WI + (size_t)row * 4) = v0;
                    u32x4 w; w.x = cvt_pk_bf16(v0[0], v0[1]); w.y = cvt_pk_bf16(v0[2], v0[3]); w.z = cvt_pk_bf16(v1[0], v1[1]); w.w = cvt_pk_bf16(v1[2], v1[3]);
                    *(u32x4*)(rowp + bj * HALF) = w; } }
    }
};
template <class Epi, class Sched, bool ALIGN_EPI = false, bool SP2 = false>
__device__ __forceinline__ void gemm_phase(PG8_LAS unsigned char* lds, const Gemm g, const Sched& S, const Epi& E, const int tid) {
    const int wid = __builtin_amdgcn_readfirstlane(tid >> 6), lane = tid & 63, wr = wid >> 2, wc = wid & 3, fr = lane & 15, fq = lane >> 4;
    const int K = g.K, nt = K / BK;
    unsigned voffA[2], voffB[2];
#pragma unroll
    for (int i = 0; i < 2; ++i) { int R, C; stage_rc(tid * 16 + i * 8192, R, C); const int Rb = Epi::PERM ? ((R & ~31) + perm32(R & 31)) : R;
        voffA[i] = (unsigned)(R * K + C) * 2u; voffB[i] = (unsigned)(Rb * K + C) * 2u; }
    const size_t kstep = (size_t)(BK * 2);
    const size_t hstep = (size_t)HALF * K * 2;
    const size_t tstep = 2 * hstep;
    const unsigned ldsw = (unsigned)wid * 1024u;
    const int aoff = lds_byte(wr * 64 + fr, fq * 8), boff = lds_byte(wc * 32 + fr, fq * 8);
#define PG8_SA(b, h) (((b) * 2 + (h)) * HTB)
#define PG8_SB(b, h) ((4 + (b) * 2 + (h)) * HTB)
#define PG8_STAGE(bufoff, gbase, voff) do { _Pragma("unroll") for (int _i = 0; _i < 2; ++_i) \
        __builtin_amdgcn_global_load_lds((const unsigned*)((const char*)(gbase) + (voff)[_i]), (PG8_LAS unsigned*)(lds + (bufoff) + ldsw + _i * 8192), 16, 0, 0); } while (0)
#define PG8_LDA(dst, b, h) do { _Pragma("unroll") for (int m = 0; m < 4; ++m) _Pragma("unroll") for (int k = 0; k < 2; ++k) dst[m][k] = *(const PG8_LAS bf16x8*)(lds + PG8_SA(b, h) + aoff + m * 2048 + k * 1024); } while (0)
#define PG8_LDB(dst, b, h) do { _Pragma("unroll") for (int n = 0; n < 2; ++n) _Pragma("unroll") for (int k = 0; k < 2; ++k) dst[n][k] = *(const PG8_LAS bf16x8*)(lds + PG8_SB(b, h) + boff + n * 2048 + k * 1024); } while (0)
#define PG8_MMA(ai, bj, At, Bt) do { __builtin_amdgcn_s_setprio(1); _Pragma("unroll") for (int m = 0; m < 4; ++m) _Pragma("unroll") for (int n = 0; n < 2; ++n) _Pragma("unroll") for (int k = 0; k < 2; ++k) \
        acc[ai][bj][m][n] = __builtin_amdgcn_mfma_f32_16x16x32_bf16(Bt[n][k], At[m][k], acc[ai][bj][m][n], 0, 0, 0); __builtin_amdgcn_s_setprio(0); } while (0)
#define PG8_WAIT_V(n) asm volatile("s_waitcnt vmcnt(" #n ")" ::: "memory")
#define PG8_WAIT_L(n) asm volatile("s_waitcnt lgkmcnt(" #n ")" ::: "memory")
#define PG8_BAR __builtin_amdgcn_s_barrier()
#define PG8_SCHED __builtin_amdgcn_sched_barrier(0)
    Unit cur, nxt; int ui = 0;
    if (!S.next(0, cur)) return;
    f32x4 acc[2][2][4][2];
#pragma unroll
    for (int a = 0; a < 2; ++a)
#pragma unroll
        for (int b = 0; b < 2; ++b)
#pragma unroll
            for (int m = 0; m < 4; ++m)
#pragma unroll
                for (int n = 0; n < 2; ++n) acc[a][b][m][n] = (f32x4){0.f, 0.f, 0.f, 0.f};
    bf16x8 At[4][2], B0[2][2], B1[2][2];
    const char* cA = (const char*)g.A + (size_t)cur.pm * tstep; const char* cB = (const char*)g.Bt + (size_t)cur.pn * tstep;
    S.a_ready(cur);
    if constexpr (SP2) {
        PG8_STAGE(PG8_SB(0, 0), cB, voffB); PG8_STAGE(PG8_SB(0, 1), cB + hstep, voffB); PG8_STAGE(PG8_SA(0, 0), cA, voffA); PG8_STAGE(PG8_SA(0, 1), cA + hstep, voffA);
        if (wr == 1) PG8_BAR;
        PG8_WAIT_V(2); PG8_BAR;
        PG8_STAGE(PG8_SB(1, 0), cB + kstep, voffB); PG8_STAGE(PG8_SA(1, 0), cA + kstep, voffA); PG8_STAGE(PG8_SB(1, 1), cB + hstep + kstep, voffB);
        PG8_WAIT_V(6); PG8_BAR;
    } else {
        PG8_STAGE(PG8_SB(0, 0), cB, voffB); PG8_STAGE(PG8_SA(0, 0), cA, voffA); PG8_STAGE(PG8_SB(0, 1), cB + hstep, voffB); PG8_STAGE(PG8_SA(0, 1), cA + hstep, voffA);
        if (wr == 1) PG8_BAR;
        PG8_WAIT_V(4); PG8_BAR;
        PG8_STAGE(PG8_SB(1, 0), cB + kstep, voffB); PG8_STAGE(PG8_SA(1, 0), cA + kstep, voffA); PG8_STAGE(PG8_SB(1, 1), cB + hstep + kstep, voffB);
        PG8_WAIT_V(6); PG8_BAR;
    }
    for (;;) {
        const bool has_next = S.next(ui + 1, nxt);
        const char* nA = has_next ? (const char*)g.A + (size_t)nxt.pm * tstep : cA; const char* nB = has_next ? (const char*)g.Bt + (size_t)nxt.pn * tstep : cB;
        for (int t = 0; t < nt; t += 2) {
            const bool last = (t == nt - 2);
            const char* a1 = cA + (size_t)(t + 1) * kstep;
            const char* a2 = last ? nA : cA + (size_t)(t + 2) * kstep; const char* b2 = last ? nB : cB + (size_t)(t + 2) * kstep;
            const char* a3 = a2 + kstep; const char* b3 = b2 + kstep;
            if (last && has_next) S.a_ready(nxt);
            if constexpr (SP2) {
            PG8_LDB(B0, 0, 0); PG8_LDB(B1, 0, 1); PG8_SCHED; PG8_LDA(At, 0, 0); PG8_STAGE(PG8_SA(1, 1), a1 + hstep, voffA);
            PG8_WAIT_V(8); PG8_WAIT_L(0); PG8_BAR; PG8_MMA(0, 0, At, B0); PG8_MMA(0, 1, At, B1); PG8_BAR; PG8_SCHED;
            PG8_LDA(At, 0, 1); PG8_STAGE(PG8_SB(0, 0), b2, voffB); PG8_STAGE(PG8_SB(0, 1), b2 + hstep, voffB); PG8_STAGE(PG8_SA(0, 0), a2, voffA);
            PG8_WAIT_V(8); PG8_WAIT_L(0); PG8_BAR; PG8_MMA(1, 0, At, B0); PG8_MMA(1, 1, At, B1); PG8_BAR; PG8_SCHED;
            PG8_LDB(B0, 1, 0); PG8_LDB(B1, 1, 1); PG8_SCHED; PG8_LDA(At, 1, 0); PG8_STAGE(PG8_SA(0, 1), a2 + hstep, voffA);
            PG8_WAIT_V(8); PG8_WAIT_L(0); PG8_BAR; PG8_MMA(0, 0, At, B0); PG8_MMA(0, 1, At, B1); PG8_BAR; PG8_SCHED;
            PG8_LDA(At, 1, 1); PG8_STAGE(PG8_SB(1, 0), b3, voffB); PG8_STAGE(PG8_SB(1, 1), b3 + hstep, voffB); PG8_STAGE(PG8_SA(1, 0), a3, voffA);
            PG8_WAIT_V(8); PG8_WAIT_L(0); PG8_BAR; PG8_MMA(1, 0, At, B0); PG8_MMA(1, 1, At, B1); PG8_BAR; PG8_SCHED;
            } else {
            PG8_LDB(B0, 0, 0); PG8_SCHED; PG8_LDA(At, 0, 0); PG8_STAGE(PG8_SA(1, 1), a1 + hstep, voffA);
            PG8_WAIT_L(8); PG8_BAR; PG8_WAIT_L(0); PG8_MMA(0, 0, At, B0); PG8_BAR; PG8_SCHED;
            PG8_LDB(B1, 0, 1); PG8_STAGE(PG8_SB(0, 0), b2, voffB);
            PG8_BAR; PG8_WAIT_L(0); PG8_MMA(0, 1, At, B1); PG8_BAR;
            PG8_LDA(At, 0, 1); PG8_STAGE(PG8_SA(0, 0), a2, voffA);
            PG8_BAR; PG8_WAIT_L(0); PG8_MMA(1, 0, At, B0); PG8_BAR; PG8_SCHED;
            PG8_STAGE(PG8_SB(0, 1), b2 + hstep, voffB);
            PG8_WAIT_V(6); PG8_BAR; PG8_MMA(1, 1, At, B1); PG8_BAR;
            PG8_LDB(B0, 1, 0); PG8_SCHED; PG8_LDA(At, 1, 0); PG8_STAGE(PG8_SA(0, 1), a2 + hstep, voffA);
            PG8_WAIT_L(8); PG8_BAR; PG8_WAIT_L(0); PG8_MMA(0, 0, At, B0); PG8_BAR; PG8_SCHED;
            PG8_LDB(B1, 1, 1); PG8_STAGE(PG8_SB(1, 0), b3, voffB);
            PG8_BAR; PG8_WAIT_L(0); PG8_MMA(0, 1, At, B1); PG8_BAR;
            PG8_LDA(At, 1, 1); PG8_STAGE(PG8_SA(1, 0), a3, voffA);
            PG8_BAR; PG8_WAIT_L(0); PG8_MMA(1, 0, At, B0); PG8_BAR; PG8_SCHED;
            PG8_STAGE(PG8_SB(1, 1), b3 + hstep, voffB);
            PG8_WAIT_V(6); PG8_BAR; PG8_MMA(1, 1, At, B1); PG8_BAR;
            }
        }
        if constexpr (ALIGN_EPI) { if (wr == 0) PG8_BAR; }
        if constexpr (!Epi::AFTER_DRAIN) { E(acc, cur, wr, wc, fr, fq); S.done(cur); }
        if (!has_next) break;
#pragma unroll
        for (int a = 0; a < 2; ++a)
#pragma unroll
            for (int b = 0; b < 2; ++b)
#pragma unroll
                for (int m = 0; m < 4; ++m)
#pragma unroll
                    for (int n = 0; n < 2; ++n) acc[a][b][m][n] = (f32x4){0.f, 0.f, 0.f, 0.f};
        cur = nxt; cA = nA; cB = nB; ++ui;
        if constexpr (ALIGN_EPI) { if (wr == 1) PG8_BAR; }
    }
    PG8_WAIT_V(0);
    if constexpr (!ALIGN_EPI) { if (wr == 0) PG8_BAR; }
    PG8_BAR;
    if constexpr (Epi::AFTER_DRAIN) { E.fused(acc, cur, wr, wc, fr, fq, lds, wid, lane); S.done(cur); }
#undef PG8_SA
#undef PG8_SB
#undef PG8_STAGE
#undef PG8_LDA
#undef PG8_LDB
#undef PG8_MMA
#undef PG8_WAIT_V
#undef PG8_WAIT_L
#undef PG8_BAR
#undef PG8_SCHED
}
}

constexpr int NB = 8, SEQ = 2048, D = 1024, NL = 4, M = NB * SEQ, FF = 2816, FF2 = 2 * FF, PW = 2884, PWP = 3072, NMOD = 9 * D;
constexpr int NWAVES = 8, NTHR = 512;
typedef unsigned short bf16;
typedef unsigned v4u __attribute__((ext_vector_type(4)));
typedef unsigned v2u __attribute__((ext_vector_type(2)));
typedef float f32x4 __attribute__((ext_vector_type(4)));
typedef short bf16x8 __attribute__((ext_vector_type(8)));
typedef short bf16x4 __attribute__((ext_vector_type(4)));
typedef unsigned long long u64;
#define LAS __attribute__((address_space(3)))

constexpr size_t MiB = 1u << 20;
constexpr size_t WS_MOD = 1 * MiB;
constexpr size_t WS_ROPE = 3 * MiB;
constexpr size_t WS_WI = 4 * MiB;
constexpr size_t WS_SGUW = 5 * MiB;
constexpr size_t WS_MASK = 6 * MiB;
constexpr size_t WS_W = 16 * MiB, W_STRIDE = 42 * MiB;
constexpr size_t WO_1IN = 0, WO_1OUT = 11 * MiB, WO_MIX = 17 * MiB, WO_OUT = 23 * MiB, WO_2IN = 25 * MiB, WO_2OUT = 36 * MiB;
constexpr size_t WS_XN = 184 * MiB;
constexpr size_t WS_CAT = 216 * MiB;
constexpr size_t WS_BIG = 248 * MiB;
constexpr size_t WS_END = 344 * MiB;

struct Args {
    const float *x, *c; const int* pos; const float *ada_w, *ada_b, *norm_ffn1, *ffn1_w_in, *ffn1_w_out, *norm_mix, *mix_w_in, *sgu_w, *sgu_b, *mix_w_out, *norm_ffn2, *ffn2_w_in, *ffn2_w_out, *final_norm;
    float* out; unsigned char* ws;
};

__device__ __forceinline__ unsigned f2bf(float f) { unsigned u = __builtin_bit_cast(unsigned, f); return (u + 0x7fffu + ((u >> 16) & 1u)) >> 16; }
__device__ __forceinline__ unsigned pk2(float lo, float hi) { return f2bf(lo) | (f2bf(hi) << 16); }
__device__ __forceinline__ float wave_sum(float v) {
#pragma unroll
    for (int o = 1; o < 64; o <<= 1) v += __shfl_xor(v, o);
    return v;
}

__device__ __forceinline__ void p0_transpose_item(const float* W, int K, int N, bf16* WT, int mode, float* scr, int item, int nblk, int lane) {
    const int kb = item / nblk, nb = item % nblk, k0 = 64 * kb, n0 = 32 * nb;
    const int nsrc = n0 + (lane & 31); const bool ok = nsrc < N;
#pragma unroll 8
    for (int i = 0; i < 32; ++i) { const int kk = 2 * i + (lane >> 5); scr[kk * 33 + (lane & 31)] = ok ? W[(size_t)(k0 + kk) * N + nsrc] : 0.f; }
    asm volatile("s_waitcnt lgkmcnt(0)" ::: "memory");
    int d0 = n0;
    if (mode == 1) { const int j = n0 < FF ? n0 : n0 - FF; d0 = 256 * (j >> 7) + (j & 127) + (n0 < FF ? 0 : 128); }
    const int c = lane & 7;
#pragma unroll
    for (int j = 0; j < 4; ++j) { const int n = (lane >> 3) + 8 * j; const float* s = scr + (8 * c) * 33 + n;
        v4u o; o.x = pk2(s[0 * 33], s[1 * 33]); o.y = pk2(s[2 * 33], s[3 * 33]); o.z = pk2(s[4 * 33], s[5 * 33]); o.w = pk2(s[6 * 33], s[7 * 33]);
        *(v4u*)(WT + (size_t)(d0 + n) * K + k0 + 8 * c) = o; }
    asm volatile("s_waitcnt lgkmcnt(0)" ::: "memory");
}

__device__ __forceinline__ void p0_prologue(const Args& A, unsigned char* lds, int vcu, int G, int tid, int wave, int lane) {
    unsigned char* ws = A.ws;
    float* cact = (float*)lds;
    float* red = (float*)(lds + 32768);
    for (int i = tid; i < NB * D; i += NTHR) { const int b = i / D, k = i % D; const float v = A.c[i]; cact[k * 8 + b] = v / (1.0f + __expf(-v)); }
    __syncthreads();
    float* mod = (float*)(ws + WS_MOD);
    for (int it = vcu; it < NL * (NMOD / 64); it += G) {
        const int l = it / (NMOD / 64), n0 = (it % (NMOD / 64)) * 64;
        const float* wp = A.ada_w + (size_t)l * D * NMOD + (size_t)(128 * wave) * NMOD + n0 + lane;
        float acc[8];
#pragma unroll
        for (int b = 0; b < 8; ++b) acc[b] = 0.f;
#pragma unroll 8
        for (int k = 0; k < 128; ++k) { const float wv = wp[(size_t)k * NMOD]; const f32x4 c0 = *(const f32x4*)(cact + (128 * wave + k) * 8), c1 = *(const f32x4*)(cact + (128 * wave + k) * 8 + 4);
            acc[0] += c0[0] * wv; acc[1] += c0[1] * wv; acc[2] += c0[2] * wv; acc[3] += c0[3] * wv; acc[4] += c1[0] * wv; acc[5] += c1[1] * wv; acc[6] += c1[2] * wv; acc[7] += c1[3] * wv; }
#pragma unroll
        for (int b = 0; b < 8; ++b) red[(wave * 8 + b) * 64 + lane] = acc[b];
        __syncthreads();
        { const int b = tid >> 6, n = tid & 63; float s = A.ada_b[(size_t)l * NMOD + n0 + n];
#pragma unroll
          for (int w = 0; w < 8; ++w) s += red[(w * 8 + b) * 64 + n];
          mod[((size_t)l * NB + b) * NMOD + n0 + n] = s; }
        __syncthreads();
    }
    const int gt = vcu * NTHR + tid, NGT = G * NTHR;
    float* rope = (float*)(ws + WS_ROPE);
    for (int i = gt; i < M * 8; i += NGT) { const int m = i >> 3, f = i & 7; const float inv = exp2f(-(float)f * (0.125f * 18.931568569324174f));
        const float ang = (float)A.pos[m] * inv; const double rev = (double)ang * 0.15915494309189535; const float fr_ = (float)(rev - floor(rev));
        rope[m * 16 + f] = __builtin_amdgcn_cosf(fr_); rope[m * 16 + 8 + f] = __builtin_amdgcn_sinf(fr_); }
    bf16* sw = (bf16*)(ws + WS_SGUW);
    for (int i = gt; i < NL * 4 * 128 * 128; i += NGT) { const int s = i & 127, t = (i >> 7) & 127; sw[i] = (bf16)(s <= t ? f2bf(A.sgu_w[i]) : 0u); }
    float* scr = (float*)(lds + wave * 16384);
    const int gw = vcu * NWAVES + wave, NGW = G * NWAVES;
    constexpr int I_IN = (D / 64) * (FF2 / 32), I_OUT = (FF / 64) * (D / 32), I_MIX = (D / 64) * (PWP / 32), I_MO = (D / 64) * (D / 32);
    constexpr int I_LAYER = 2 * I_IN + 2 * I_OUT + I_MIX + I_MO;
    for (int it = gw; it < NL * I_LAYER; it += NGW) {
        const int l = it / I_LAYER; int r = it % I_LAYER; unsigned char* wl = ws + WS_W + (size_t)l * W_STRIDE;
        if (r < I_IN) { p0_transpose_item(A.ffn1_w_in + (size_t)l * D * FF2, D, FF2, (bf16*)(wl + WO_1IN), 1, scr, r, FF2 / 32, lane); continue; } r -= I_IN;
        if (r < I_IN) { p0_transpose_item(A.ffn2_w_in + (size_t)l * D * FF2, D, FF2, (bf16*)(wl + WO_2IN), 1, scr, r, FF2 / 32, lane); continue; } r -= I_IN;
        if (r < I_OUT) { p0_transpose_item(A.ffn1_w_out + (size_t)l * FF * D, FF, D, (bf16*)(wl + WO_1OUT), 0, scr, r, D / 32, lane); continue; } r -= I_OUT;
        if (r < I_OUT) { p0_transpose_item(A.ffn2_w_out + (size_t)l * FF * D, FF, D, (bf16*)(wl + WO_2OUT), 0, scr, r, D / 32, lane); continue; } r -= I_OUT;
        if (r < I_MIX) { p0_transpose_item(A.mix_w_in + (size_t)l * D * PW, D, PW, (bf16*)(wl + WO_MIX), 0, scr, r, PWP / 32, lane); continue; } r -= I_MIX;
        p0_transpose_item(A.mix_w_out + (size_t)l * D * D, D, D, (bf16*)(wl + WO_OUT), 0, scr, r, D / 32, lane);
    }
}

__device__ __forceinline__ void norm_mod_phase(const float* x, const float* g, const float* shift, const float* scale, bf16* XN, int vcu, int G, int wave, int lane) {
    const int gw = vcu * NWAVES + wave, NGW = G * NWAVES;
    for (int blk = gw; blk < M / 8; blk += NGW) {
        const int m0 = blk * 8, b = m0 / SEQ;
        f32x4 gm[4], sh[4];
#pragma unroll
        for (int j = 0; j < 4; ++j) { const int k = 4 * lane + 256 * j; gm[j] = *(const f32x4*)(g + k) * (*(const f32x4*)(scale + (size_t)b * NMOD + k) + 1.0f); sh[j] = *(const f32x4*)(shift + (size_t)b * NMOD + k); }
        for (int r = 0; r < 8; ++r) {
            const float* xr = x + (size_t)(m0 + r) * D; f32x4 v[4]; float s = 0.f;
#pragma unroll
            for (int j = 0; j < 4; ++j) { v[j] = *(const f32x4*)(xr + 4 * lane + 256 * j); s += (v[j][0] * v[j][0] + v[j][1] * v[j][1]) + (v[j][2] * v[j][2] + v[j][3] * v[j][3]); }
            const float rstd = 1.0f / sqrtf(wave_sum(s) * (1.0f / D) + 1e-6f);
            bf16* orow = XN + (size_t)(m0 + r) * D;
#pragma unroll
            for (int j = 0; j < 4; ++j) { const f32x4 o = v[j] * rstd * gm[j] + sh[j]; v2u w; w.x = pk2(o[0], o[1]); w.y = pk2(o[2], o[3]); *(v2u*)(orow + 4 * lane + 256 * j) = w; }
        }
    }
}
__device__ __forceinline__ void final_norm_phase(float* x, const float* g, int vcu, int G, int wave, int lane) {
    const int gw = vcu * NWAVES + wave, NGW = G * NWAVES;
    f32x4 gm[4];
#pragma unroll
    for (int j = 0; j < 4; ++j) gm[j] = *(const f32x4*)(g + 4 * lane + 256 * j);
    for (int m = gw; m < M; m += NGW) {
        float* xr = x + (size_t)m * D; f32x4 v[4]; float s = 0.f;
#pragma unroll
        for (int j = 0; j < 4; ++j) { v[j] = *(const f32x4*)(xr + 4 * lane + 256 * j); s += (v[j][0] * v[j][0] + v[j][1] * v[j][1]) + (v[j][2] * v[j][2] + v[j][3] * v[j][3]); }
        const float rstd = 1.0f / sqrtf(wave_sum(s) * (1.0f / D) + 1e-6f);
#pragma unroll
        for (int j = 0; j < 4; ++j) *(f32x4*)(xr + 4 * lane + 256 * j) = v[j] * rstd * gm[j];
    }
}

constexpr int SGU_PITCH = 260;
__device__ __forceinline__ void sgu_item(const bf16* P, const bf16* sw  , const float* sb  , bf16* CAT, unsigned char* lds, int item, int tid, int wave, int lane) {
    const int g = item & 3, ch = (item >> 2) & 15, b = item >> 6; const int fr = lane & 15, fq = lane >> 4;
    const size_t tok0 = (size_t)b * SEQ + ch * 128;
    __syncthreads();
#pragma unroll
    for (int i = 0; i < 4; ++i) { const int p = tid + i * NTHR, row = p >> 4, cc = p & 15; const v4u v = *(const v4u*)(P + (tok0 + row) * pg8::PROW + 512 + g * 128 + cc * 8);
        unsigned* d = (unsigned*)(lds + row * SGU_PITCH + cc * 16); d[0] = v.x; d[1] = v.y; d[2] = v.z; d[3] = v.w; }
    __syncthreads();
    bf16x8 yf[4];
#pragma unroll
    for (int ks = 0; ks < 4; ++ks)
#pragma unroll
        for (int j = 0; j < 8; ++j) yf[ks][j] = (short)*(const unsigned short*)(lds + (32 * ks + 8 * fq + j) * SGU_PITCH + (16 * wave + fr) * 2);
    const bf16* wg = sw + (size_t)g * 128 * 128;
#pragma unroll
    for (int tt = 0; tt < 8; ++tt) {
        f32x4 acc = (f32x4){0.f, 0.f, 0.f, 0.f};
#pragma unroll
        for (int ks = 0; ks <= tt / 2; ++ks) { const bf16x8 xf = *(const bf16x8*)(wg + (size_t)(16 * tt + fr) * 128 + 32 * ks + 8 * fq); acc = __builtin_amdgcn_mfma_f32_16x16x32_bf16(xf, yf[ks], acc, 0, 0, 0); }
        const int c = 128 * g + 16 * wave + fr;
#pragma unroll
        for (int ii = 0; ii < 4; ++ii) { const int t = 16 * tt + 4 * fq + ii; const size_t tok = tok0 + t;
            const float uu = __uint_as_float((unsigned)P[tok * pg8::PROW + c] << 16);
            CAT[tok * D + c] = (bf16)f2bf((acc[ii] + sb[g * 128 + t]) * uu); }
    }
}

constexpr int KI_PITCH = 144, KI_TILE = 128 * KI_PITCH;
__device__ __forceinline__ u64 causal_bits(int t, int k) { const int n = t - 64 * k + 1; return n >= 64 ? ~0ull : (n <= 0 ? 0ull : ((1ull << n) - 1ull)); }
__device__ __forceinline__ unsigned grp_sum16(unsigned v) { v += __shfl_xor(v, 1); v += __shfl_xor(v, 2); v += __shfl_xor(v, 4); v += __shfl_xor(v, 8); return v; }
__device__ __forceinline__ void indexer_item(const bf16* P, const float* WI, u64* MASK, unsigned char* lds, int b, int j, int tid, int wave, int lane) {
    const int fr = lane & 15, fq = lane >> 4; const int t_own = 32 * j + 4 * wave + fq; const int nt = j / 4 + 1;
    u64* mrow = MASK + ((size_t)b * SEQ + t_own) * 32;
    if (j < 8) {
        for (int k = fr; k < 2 * nt; k += 16) mrow[k] = causal_bits(t_own, k);
        return;
    }
    const bf16* Pb = P + (size_t)b * SEQ * pg8::PROW;
    bf16x8 xq0, xq1;
    { const bf16* qp = Pb + (size_t)(32 * j + 4 * wave + (fr >> 2)) * pg8::PROW + 2560 + (fr & 3) * 64 + 8 * fq; xq0 = *(const bf16x8*)qp; xq1 = *(const bf16x8*)(qp + 32); }
    const f32x4 wv = *(const f32x4*)(WI + ((size_t)b * SEQ + t_own) * 4);
    unsigned sk[128]; const int rel = t_own - fr;
    const bf16* kisrc = Pb + 2816;
    v4u st0, st1;
    const bf16* kp0 = kisrc + (size_t)(tid >> 3) * pg8::PROW + (tid & 7) * 8; const bf16* kp1 = kisrc + (size_t)((tid + NTHR) >> 3) * pg8::PROW + (tid & 7) * 8;
#define KI_LOAD(tile) do { st0 = *(const v4u*)kp0; st1 = *(const v4u*)kp1; kp0 += 128 * pg8::PROW; kp1 += 128 * pg8::PROW; asm volatile("" : "+v"(kp0), "+v"(kp1)); } while (0)
#define KI_STORE(buf) do { const int p0_ = tid, p1_ = tid + NTHR; *(v4u*)(lds + (buf) * KI_TILE + (p0_ >> 3) * KI_PITCH + (p0_ & 7) * 16) = st0; *(v4u*)(lds + (buf) * KI_TILE + (p1_ >> 3) * KI_PITCH + (p1_ & 7) * 16) = st1; } while (0)
    __syncthreads();
    KI_LOAD(0); KI_STORE(0);
    __syncthreads();
#pragma unroll
    for (int tile = 0; tile < 16; ++tile) {
        {
            if (tile + 1 < 16) KI_LOAD(tile + 1);
            const unsigned char* kb = lds + (tile & 1) * KI_TILE;
#pragma unroll
            for (int nb = 0; nb < 8; ++nb) {
                const bf16x8 y0 = *(const bf16x8*)(kb + (16 * nb + fr) * KI_PITCH + 16 * fq), y1 = *(const bf16x8*)(kb + (16 * nb + fr) * KI_PITCH + 16 * fq + 64);
                f32x4 a = __builtin_amdgcn_mfma_f32_16x16x32_bf16(xq0, y0, (f32x4){0.f, 0.f, 0.f, 0.f}, 0, 0, 0);
                a = __builtin_amdgcn_mfma_f32_16x16x32_bf16(xq1, y1, a, 0, 0, 0);
                float sc = wv[0] * fmaxf(a[0], 0.f) + wv[1] * fmaxf(a[1], 0.f) + wv[2] * fmaxf(a[2], 0.f) + wv[3] * fmaxf(a[3], 0.f);
                sc = (sc == 0.f) ? 0.f : sc;
                const unsigned ub = __float_as_uint(sc); unsigned key = ub ^ ((unsigned)((int)ub >> 31) | 0x80000000u);
                sk[tile * 8 + nb] = (rel >= 128 * tile + 16 * nb) ? key : 0u;
                __builtin_amdgcn_sched_barrier(0);
            }
            if (tile + 1 < 16) KI_STORE((tile + 1) & 1);
            __syncthreads();
        }
    }
#undef KI_LOAD
#undef KI_STORE
    unsigned T = 0u, cntT = 4096u;
    for (int bit = 31; bit >= 0; --bit) {
        const unsigned cand = T | (1u << bit); unsigned c = 0u;
#pragma unroll
        for (int tile = 0; tile < 16; ++tile) if (tile < nt) {
#pragma unroll
            for (int nb = 0; nb < 8; ++nb) c += (sk[tile * 8 + nb] >= cand) ? 1u : 0u; }
        c = grp_sum16(c);
        if (c >= 256u) { T = cand; cntT = c; }
        if (__all(cntT == 256u)) break;
    }
    const bool tie_any = __any(cntT != 256u);
    unsigned need = 0u, running = 0u;
    if (tie_any) { unsigned c = 0u;
#pragma unroll
        for (int tile = 0; tile < 16; ++tile) if (tile < nt) {
#pragma unroll
            for (int nb = 0; nb < 8; ++nb) c += (sk[tile * 8 + nb] > T) ? 1u : 0u; }
        c = grp_sum16(c); need = 256u - c; }
    u64 word = 0ull;
#pragma unroll
    for (int tile = 0; tile < 16; ++tile) if (tile < nt) {
#pragma unroll
        for (int nb = 0; nb < 8; ++nb) { const int r = tile * 8 + nb; const unsigned v = sk[r]; bool sel;
            if (tie_any) { const bool eq = (v == T); const u64 be = __ballot(eq); const unsigned pe = (unsigned)(be >> (16 * fq)) & 0xFFFFu;
                const unsigned before = running + __popc(pe & ((1u << fr) - 1u)); sel = (v > T) || (eq && before < need); running += __popc(pe); }
            else sel = v >= T;
            const u64 bs = __ballot(sel); const unsigned ps = (unsigned)(bs >> (16 * fq)) & 0xFFFFu;
            word |= (u64)ps << (16 * (r & 3));
            if ((r & 3) == 3) { if (fr == 0) mrow[r >> 2] = word; word = 0ull; } } }
}

constexpr int AT_PITCH = 144, AT_TILE = 64 * AT_PITCH;
__device__ __forceinline__ void attn_unit(const bf16* P, const u64* MASK, bf16* CAT, unsigned char* lds, int b, int h, int qb, int tid, int wave, int lane) {
    const int fr = lane & 15, fq = lane >> 4; const int q0 = 128 * qb + 16 * wave;
    const bf16* Pb = P + (size_t)b * SEQ * pg8::PROW;
    bf16x8 qf0, qf1;
    { const bf16* qp = Pb + (size_t)(q0 + fr) * pg8::PROW + 1024 + h * 64 + 8 * fq; qf0 = *(const bf16x8*)qp; qf1 = *(const bf16x8*)(qp + 32); }
    const u64* mrow = MASK + ((size_t)b * SEQ + q0 + fr) * 32;
    f32x4 o[4];
#pragma unroll
    for (int i = 0; i < 4; ++i) o[i] = (f32x4){0.f, 0.f, 0.f, 0.f};
    float mrun = -1e30f, lrun = 0.f;
    const int NT = 2 * (qb + 1);
    const int kkey = tid >> 3, kch = tid & 7, vkey = tid & 63, vch = tid >> 6;
    const bf16* ksrc = Pb + (size_t)kkey * pg8::PROW + 1536 + h * 64 + kch * 8;
    const bf16* vsrc = Pb + (size_t)vkey * pg8::PROW + 2048 + h * 64 + vch * 8;
    v4u kreg, vreg;
#define AT_LOAD(t) do { kreg = *(const v4u*)(ksrc + (size_t)(64 * (t)) * pg8::PROW); vreg = *(const v4u*)(vsrc + (size_t)(64 * (t)) * pg8::PROW); } while (0)
#define AT_STORE(buf) do { *(v4u*)(lds + (buf) * AT_TILE + kkey * AT_PITCH + kch * 16) = kreg; \
        unsigned short* vd_ = (unsigned short*)(lds + (2 + (buf)) * AT_TILE + (vch * 8) * AT_PITCH + vkey * 2); \
        vd_[0] = (unsigned short)vreg.x; vd_[AT_PITCH / 2] = (unsigned short)(vreg.x >> 16); vd_[2 * (AT_PITCH / 2)] = (unsigned short)vreg.y; vd_[3 * (AT_PITCH / 2)] = (unsigned short)(vreg.y >> 16); \
        vd_[4 * (AT_PITCH / 2)] = (unsigned short)vreg.z; vd_[5 * (AT_PITCH / 2)] = (unsigned short)(vreg.z >> 16); vd_[6 * (AT_PITCH / 2)] = (unsigned short)vreg.w; vd_[7 * (AT_PITCH / 2)] = (unsigned short)(vreg.w >> 16); } while (0)
    __syncthreads();
    AT_LOAD(0); AT_STORE(0);
    __syncthreads();
    const float CS = 0.125f * 1.4426950408889634f;
    for (int t = 0; t < (ATT_TRIVIAL ? 0 : NT); ++t) {
        if (t + 1 < NT) AT_LOAD(t + 1);
        const u64 mw = (ATT_IGNORE_MASK ? causal_bits(q0 + fr, t) : mrow[t]) >> (4 * fq);
        const unsigned mlo = (unsigned)mw, mhi = (unsigned)(mw >> 32);
        const unsigned char* kb = lds + (t & 1) * AT_TILE; const unsigned char* vb = lds + (2 + (t & 1)) * AT_TILE;
        f32x4 s[4];
#pragma unroll
        for (int nb = 0; nb < 4; ++nb) {
            const bf16x8 k0 = *(const bf16x8*)(kb + (16 * nb + fr) * AT_PITCH + 16 * fq), k1 = *(const bf16x8*)(kb + (16 * nb + fr) * AT_PITCH + 16 * fq + 64);
            s[nb] = __builtin_amdgcn_mfma_f32_16x16x32_bf16(k0, qf0, (f32x4){0.f, 0.f, 0.f, 0.f}, 0, 0, 0);
            s[nb] = __builtin_amdgcn_mfma_f32_16x16x32_bf16(k1, qf1, s[nb], 0, 0, 0);
        }
        float tmax = -1e30f;
#pragma unroll
        for (int nb = 0; nb < 4; ++nb) { const unsigned mbits = ((nb & 2) ? mhi : mlo) >> (16 * (nb & 1));
#pragma unroll
            for (int ii = 0; ii < 4; ++ii) { const float v = ((mbits >> ii) & 1u) ? s[nb][ii] * CS : -1e30f; s[nb][ii] = v; tmax = fmaxf(tmax, v); } }
        tmax = fmaxf(tmax, __shfl_xor(tmax, 16)); tmax = fmaxf(tmax, __shfl_xor(tmax, 32));
        const float mnew = fmaxf(mrun, tmax), alpha = __builtin_amdgcn_exp2f(mrun - mnew); mrun = mnew;
        float psum = 0.f;
#pragma unroll
        for (int nb = 0; nb < 4; ++nb)
#pragma unroll
            for (int ii = 0; ii < 4; ++ii) { const float p = __builtin_amdgcn_exp2f(s[nb][ii] - mnew); s[nb][ii] = p; psum += p; }
        lrun = lrun * alpha + psum;
#pragma unroll
        for (int i = 0; i < 4; ++i) o[i] = o[i] * alpha;
        bf16x8 pk[2];
#pragma unroll
        for (int ss = 0; ss < 2; ++ss) { v4u w; w.x = pg8::cvt_pk_bf16(s[2 * ss][0], s[2 * ss][1]); w.y = pg8::cvt_pk_bf16(s[2 * ss][2], s[2 * ss][3]); w.z = pg8::cvt_pk_bf16(s[2 * ss + 1][0], s[2 * ss + 1][1]); w.w = pg8::cvt_pk_bf16(s[2 * ss + 1][2], s[2 * ss + 1][3]);
            pk[ss] = __builtin_bit_cast(bf16x8, w); }
#pragma unroll
        for (int db = 0; db < 4; ++db)
#pragma unroll
            for (int ss = 0; ss < 2; ++ss) { const unsigned char* vp = vb + (16 * db + fr) * AT_PITCH + (32 * ss + 4 * fq) * 2;
                const v2u a0 = *(const v2u*)vp, a1 = *(const v2u*)(vp + 32); v4u aw; aw.x = a0.x; aw.y = a0.y; aw.z = a1.x; aw.w = a1.y;
                o[db] = __builtin_amdgcn_mfma_f32_16x16x32_bf16(__builtin_bit_cast(bf16x8, aw), pk[ss], o[db], 0, 0, 0); }
        if (t + 1 < NT) AT_STORE((t + 1) & 1);
        __syncthreads();
    }
#undef AT_LOAD
#undef AT_STORE
    lrun += __shfl_xor(lrun, 16); lrun += __shfl_xor(lrun, 32);
    const float inv = ATT_TRIVIAL ? 1.0f : 1.0f / lrun; if (ATT_TRIVIAL) { for (int i = 0; i < 4; ++i) o[i] = (f32x4){0.01f * fr, 0.02f * fq, 0.001f * (float)qf0[0], 0.5f}; }
    bf16* orow = CAT + ((size_t)b * SEQ + q0 + fr) * D + 512 + h * 64 + 4 * fq;
#pragma unroll
    for (int db = 0; db < 4; ++db) { v2u w; w.x = pg8::cvt_pk_bf16(o[db][0] * inv, o[db][1] * inv); w.y = pg8::cvt_pk_bf16(o[db][2] * inv, o[db][3] * inv); *(v2u*)(orow + 16 * db) = w; }
}

#ifndef PHM
#define PHM 0xFFFF
#endif
constexpr int LDS_BYTES = 147456;
__global__ void __launch_bounds__(NTHR, 2) mega_fwd(Args A) {
    extern __shared__ __attribute__((aligned(16))) unsigned char lds[];
    cg::grid_group grid = cg::this_grid();
#define GSYNC() do { __builtin_amdgcn_fence(__ATOMIC_RELEASE, "agent"); asm volatile("s_waitcnt vmcnt(0) lgkmcnt(0)" ::: "memory"); grid.sync(); __builtin_amdgcn_fence(__ATOMIC_ACQUIRE, "agent"); asm volatile("s_waitcnt vmcnt(0)" ::: "memory"); __syncthreads(); } while (0)
    const int tid = threadIdx.x, lane = tid & 63, wave = __builtin_amdgcn_readfirstlane(tid >> 6);
    const int G = gridDim.x, bx = blockIdx.x; const int vcu = (G % 8 == 0) ? (bx % 8) * (G / 8) + bx / 8 : bx;
    unsigned char* ws = A.ws;
    PG8_LAS unsigned char* lds3 = (PG8_LAS unsigned char*)lds;
    float* xres = A.out;
    const float* mod = (const float*)(ws + WS_MOD); const float* rope = (const float*)(ws + WS_ROPE); float* WI = (float*)(ws + WS_WI);
    u64* MASK = (u64*)(ws + WS_MASK); bf16* XN = (bf16*)(ws + WS_XN); bf16* CAT = (bf16*)(ws + WS_CAT); bf16* BIG = (bf16*)(ws + WS_BIG);

    if (PHM & 1) p0_prologue(A, lds, vcu, G, tid, wave, lane);
    GSYNC();
    for (int l = 0; l < NL; ++l) {
        int tid_o = tid, lane_o, wave_o;
#define OPQ() do { tid_o = tid; asm volatile("" : "+v"(tid_o)); lane_o = tid_o & 63; wave_o = __builtin_amdgcn_readfirstlane(tid_o >> 6); } while (0)
        OPQ();
        const float* modl = mod + (size_t)l * NB * NMOD; unsigned char* wl = ws + WS_W + (size_t)l * W_STRIDE;
        const float* xin = (l == 0) ? A.x : xres;
        if (PHM & 2) norm_mod_phase(xin, A.norm_ffn1 + l * D, modl + 0 * D, modl + 1 * D, XN, vcu, G, wave_o, lane_o);
        GSYNC();
        OPQ();
        if (PHM & 4) { pg8::Gemm g{XN, (const bf16*)(wl + WO_1IN), M, FF2, D}; pg8::StaticOrder S; S.init(M, FF2, G, bx); pg8::EpiSwiGLU E{BIG, FF};
          pg8::gemm_phase<pg8::EpiSwiGLU, pg8::StaticOrder, true, true>(lds3, g, S, E, tid_o); }
        GSYNC();
        OPQ();
        if (PHM & 8) { pg8::Gemm g{BIG, (const bf16*)(wl + WO_1OUT), M, D, FF}; pg8::StaticOrder S; S.init(M, D, G, bx); pg8::EpiResid E{xin, xres, modl + 2 * D, NMOD, 0.5f};
          pg8::gemm_phase<pg8::EpiResid, pg8::StaticOrder, true, true>(lds3, g, S, E, tid_o); }
        GSYNC();
        OPQ();
        if (PHM & 2) norm_mod_phase(xres, A.norm_mix + l * D, modl + 3 * D, modl + 4 * D, XN, vcu, G, wave_o, lane_o);
        GSYNC();
        OPQ();
        if (PHM & 16) { pg8::Gemm g{XN, (const bf16*)(wl + WO_MIX), M, PWP, D}; pg8::StaticOrder S; S.init(M, PWP, G, bx); pg8::EpiProj E{BIG, WI, rope};
          pg8::gemm_phase<pg8::EpiProj, pg8::StaticOrder, true, true>(lds3, g, S, E, tid_o); }
        GSYNC();
        OPQ();
        {
          if (PHM & 32) for (int it = vcu; it < NB * 32; it += G) { const int b = it >> 5, s = it & 31;
              for (int rep = 0; rep < 2; ++rep) indexer_item(BIG, WI, MASK, lds, b, rep ? 63 - s : s, tid_o, wave_o, lane_o); }
          const bf16* sw = (const bf16*)(ws + WS_SGUW) + (size_t)l * 4 * 128 * 128; const float* sb = A.sgu_b + (size_t)l * 4 * 128;
          if (PHM & 64) for (int it = vcu; it < NB * 16 * 4; it += G) sgu_item(BIG, sw, sb, CAT, lds, it, tid_o, wave_o, lane_o);
        }
        GSYNC();
        OPQ();
        if (PHM & 128) { for (int it = vcu; it < NB * 8 * 4; it += G) { const int bh = it >> 2, s = it & 3; const int b = bh >> 3, h = bh & 7;
              attn_unit(BIG, MASK, CAT, lds, b, h, 15 - s, tid_o, wave_o, lane_o); attn_unit(BIG, MASK, CAT, lds, b, h, s, tid_o, wave_o, lane_o);
              attn_unit(BIG, MASK, CAT, lds, b, h, 8 + s, tid_o, wave_o, lane_o); attn_unit(BIG, MASK, CAT, lds, b, h, 7 - s, tid_o, wave_o, lane_o); } }
        GSYNC();
        OPQ();
        if (PHM & 256) { pg8::Gemm g{CAT, (const bf16*)(wl + WO_OUT), M, D, D}; pg8::StaticOrder S; S.init(M, D, G, bx); pg8::EpiResid E{xres, xres, modl + 5 * D, NMOD, 1.0f};
          pg8::gemm_phase<pg8::EpiResid, pg8::StaticOrder, true, true>(lds3, g, S, E, tid_o); }
        GSYNC();
        OPQ();
        if (PHM & 2) norm_mod_phase(xres, A.norm_ffn2 + l * D, modl + 6 * D, modl + 7 * D, XN, vcu, G, wave_o, lane_o);
        GSYNC();
        OPQ();
        if (PHM & 512) { pg8::Gemm g{XN, (const bf16*)(wl + WO_2IN), M, FF2, D}; pg8::StaticOrder S; S.init(M, FF2, G, bx); pg8::EpiSwiGLU E{BIG, FF};
          pg8::gemm_phase<pg8::EpiSwiGLU, pg8::StaticOrder, true, true>(lds3, g, S, E, tid_o); }
        GSYNC();
        OPQ();
        if (PHM & 1024) { pg8::Gemm g{BIG, (const bf16*)(wl + WO_2OUT), M, D, FF}; pg8::StaticOrder S; S.init(M, D, G, bx); pg8::EpiResid E{xres, xres, modl + 8 * D, NMOD, 0.5f};
          pg8::gemm_phase<pg8::EpiResid, pg8::StaticOrder, true, true>(lds3, g, S, E, tid_o); }
        GSYNC();
        OPQ();
    }
    if (PHM & 2048) final_norm_phase(xres, A.final_norm, vcu, G, wave, lane);
}

extern "C" void kernel_launch(void* const* d_in, const int* in_sizes, int n_in, void* d_out, int out_size, void* d_ws, size_t ws_size, hipStream_t stream) {
    static int grid = 0;
    if (grid == 0) {
        if (n_in != 17 || in_sizes[0] != M * D || out_size != M * D || ws_size < WS_END) { fprintf(stderr, "kernel_launch: unexpected shapes/workspace (n_in %d, in0 %d, out %d, ws %zu, need %zu)\n", n_in, n_in > 0 ? in_sizes[0] : -1, out_size, ws_size, (size_t)WS_END); grid = -1; return; }
        int dev = 0, cus = 0, per_cu = 0;
        (void)hipGetDevice(&dev); (void)hipDeviceGetAttribute(&cus, hipDeviceAttributeMultiprocessorCount, dev);
        if (hipFuncSetAttribute((const void*)mega_fwd, hipFuncAttributeMaxDynamicSharedMemorySize, LDS_BYTES) != hipSuccess) { fprintf(stderr, "kernel_launch: hipFuncSetAttribute failed\n"); grid = -1; return; }
        if (hipOccupancyMaxActiveBlocksPerMultiprocessor(&per_cu, (const void*)mega_fwd, NTHR, LDS_BYTES) != hipSuccess || per_cu < 1) { fprintf(stderr, "kernel_launch: occupancy query gave %d\n", per_cu); per_cu = 1; }
        (void)hipGetLastError();
        grid = cus * per_cu;
    }
    if (grid < 0) return;
    Args a{};
    a.x = (const float*)d_in[0]; a.c = (const float*)d_in[1]; a.pos = (const int*)d_in[2]; a.ada_w = (const float*)d_in[3]; a.ada_b = (const float*)d_in[4];
    a.norm_ffn1 = (const float*)d_in[5]; a.ffn1_w_in = (const float*)d_in[6]; a.ffn1_w_out = (const float*)d_in[7]; a.norm_mix = (const float*)d_in[8]; a.mix_w_in = (const float*)d_in[9];
    a.sgu_w = (const float*)d_in[10]; a.sgu_b = (const float*)d_in[11]; a.mix_w_out = (const float*)d_in[12]; a.norm_ffn2 = (const float*)d_in[13]; a.ffn2_w_in = (const float*)d_in[14];
    a.ffn2_w_out = (const float*)d_in[15]; a.final_norm = (const float*)d_in[16]; a.out = (float*)d_out; a.ws = (unsigned char*)d_ws;
    void* args[] = {&a};
    hipError_t e = hipLaunchCooperativeKernel((const void*)mega_fwd, dim3(grid), dim3(NTHR), args, LDS_BYTES, stream);
    if (e != hipSuccess) fprintf(stderr, "kernel_launch: cooperative launch failed: %s (grid %d)\n", hipGetErrorString(e), grid);
}
```

```cpp
#include <hip/hip_runtime.h>
#include <hip/hip_cooperative_groups.h>
#include <cstdio>
#include <cstdint>
namespace cg = cooperative_groups;
#ifndef ATT_TRIVIAL
#define ATT_TRIVIAL 0
#endif
#ifndef ATT_IGNORE_MASK
#define ATT_IGNORE_MASK 0
#endif
namespace pg8 {
#define PG8_LAS __attribute__((address_space(3)))
typedef unsigned short bf16_t;
typedef short bf16x8 __attribute__((ext_vector_type(8)));
typedef float f32x4 __attribute__((ext_vector_type(4)));
typedef unsigned u32x4 __attribute__((ext_vector_type(4)));
constexpr int BM = 256, BK = 64, HALF = 128, HTB = HALF * BK * 2  , STAGE_BYTES = 8 * HTB, NXCD = 8, WGM = 8;

__host__ __device__ __forceinline__ int lds_byte(int r, int c) { const int st = (r >> 4) * 2 + (c >> 5), rr = r & 15, cc = c & 31, ob = rr * 64 + cc * 2; return st * 1024 + (ob ^ (((ob >> 9) & 1) << 5)); }
__host__ __device__ __forceinline__ void stage_rc(int b, int& R, int& C) { const int st = b / 1024, sb = b % 1024, swz = sb ^ (((sb >> 9) & 1) << 5); R = (st >> 1) * 16 + swz / 64; C = (st & 1) * 32 + (swz % 64) / 2; }
__host__ __device__ __forceinline__ int perm32(int rho) { const int n = rho >> 4, i = rho & 15; return 8 * (i >> 2) + 4 * n + (i & 3); }

struct Unit { int pm, pn; };
struct Gemm { const bf16_t* A; const bf16_t* Bt; int M, N, K; };

struct StaticOrder {
    int nM, nN, nwg, G, c;
    __host__ __device__ void init(int M, int N, int G_, int c_) { nM = M / BM; nN = N / BM; nwg = nM * nN; G = G_; c = c_; }
    __host__ __device__ bool next(int i, Unit& u) const {
        const long L = (long)i * G + c; if (L >= nwg) return false;
        int wgid = (int)L; { const int q = nwg / NXCD, r = nwg % NXCD, xcd = wgid % NXCD, off = wgid / NXCD; wgid = (xcd < r ? xcd * (q + 1) : r * (q + 1) + (xcd - r) * q) + off; }
        const int nig = WGM * nN, gid = wgid / nig, fm = gid * WGM, gsz = (nM - fm) < WGM ? (nM - fm) : WGM;
        u.pm = fm + ((wgid % nig) % gsz); u.pn = (wgid % nig) / gsz; return true;
    }
    __device__ __forceinline__ void a_ready(const Unit&) const {}
    __device__ __forceinline__ void done(const Unit&) const {}
};

typedef float f32x2_t __attribute__((ext_vector_type(2))); typedef __bf16 bf16x2_t __attribute__((ext_vector_type(2)));
__device__ __forceinline__ unsigned cvt_pk_bf16(float lo, float hi) { f32x2_t v = {lo, hi}; bf16x2_t b = __builtin_convertvector(v, bf16x2_t); return __builtin_bit_cast(unsigned, b); }
typedef float f32x2 __attribute__((ext_vector_type(2)));
__device__ __forceinline__ f32x2 gelu_pk(f32x2 v) {
    const f32x2 av = __builtin_elementwise_abs(v), d = av * 0.2316418882f + 1.0f;
    f32x2 t; t.x = __builtin_amdgcn_rcpf(d.x); t.y = __builtin_amdgcn_rcpf(d.y);
    f32x2 q = t * 0.5307027145f + (-0.7265760135f); q = q * t + 0.7107068705f; q = q * t + (-0.142248368f); q = q * t + 0.127414796f; q = q * t;
    const f32x2 s = (v * v) * (-0.72134752044f);
    f32x2 e; e.x = __builtin_amdgcn_exp2f(s.x); e.y = __builtin_amdgcn_exp2f(s.y);
    const f32x2 m = v * (q * e), r = v - m;
    f32x2 o; o.x = v.x < 0.f ? m.x : r.x; o.y = v.y < 0.f ? m.y : r.y; return o;
}


constexpr int PROW = 3072;
__device__ __forceinline__ float silu_f(float g) { return g * __builtin_amdgcn_rcpf(1.0f + __builtin_amdgcn_exp2f(-1.4426950408889634f * g)); }
struct EpiSwiGLU {
    static constexpr bool PERM = true, AFTER_DRAIN = false;
    bf16_t* O; int ldc;
    __device__ __forceinline__ void operator()(const f32x4 (&acc)[2][2][4][2], const Unit& u, int wr, int wc, int fr, int fq) const {
        const int row0 = u.pm * BM + wr * 64 + fr, col0 = u.pn * HALF + wc * 32 + 8 * fq;
#pragma unroll
        for (int ai = 0; ai < 2; ++ai)
#pragma unroll
            for (int m = 0; m < 4; ++m) { bf16_t* rowp = O + (size_t)(row0 + ai * HALF + m * 16) * ldc + col0;
                const f32x4 g0 = acc[ai][0][m][0], g1 = acc[ai][0][m][1], u0 = acc[ai][1][m][0], u1 = acc[ai][1][m][1];
                u32x4 w; w.x = cvt_pk_bf16(silu_f(g0[0]) * u0[0], silu_f(g0[1]) * u0[1]); w.y = cvt_pk_bf16(silu_f(g0[2]) * u0[2], silu_f(g0[3]) * u0[3]);
                w.z = cvt_pk_bf16(silu_f(g1[0]) * u1[0], silu_f(g1[1]) * u1[1]); w.w = cvt_pk_bf16(silu_f(g1[2]) * u1[2], silu_f(g1[3]) * u1[3]);
                *(u32x4*)rowp = w; }
    }
};
struct EpiResid {
    static constexpr bool PERM = false, AFTER_DRAIN = false;
    const float* base; float* out; const float* gate; int gpitch; float coef;
    __device__ __forceinline__ void operator()(const f32x4 (&acc)[2][2][4][2], const Unit& u, int wr, int wc, int fr, int fq) const {
        const int row0 = u.pm * BM + wr * 64 + fr, col0 = u.pn * BM + wc * 32 + 4 * fq;
        const float* gp = gate + (size_t)(u.pm >> 3) * gpitch + col0;
        f32x4 gv[2][2];
#pragma unroll
        for (int bj = 0; bj < 2; ++bj)
#pragma unroll
            for (int n = 0; n < 2; ++n) gv[bj][n] = *(const f32x4*)(gp + bj * HALF + n * 16) * coef;
#pragma unroll
        for (int ai = 0; ai < 2; ++ai)
#pragma unroll
            for (int m = 0; m < 4; ++m) { const size_t off = (size_t)(row0 + ai * HALF + m * 16) * 1024 + col0;
#pragma unroll
                for (int bj = 0; bj < 2; ++bj)
#pragma unroll
                    for (int n = 0; n < 2; ++n) *(f32x4*)(out + off + bj * HALF + n * 16) = *(const f32x4*)(base + off + bj * HALF + n * 16) + gv[bj][n] * acc[ai][bj][m][n]; }
    }
};
struct EpiProj {
    static constexpr bool PERM = true, AFTER_DRAIN = false;
    bf16_t* P; float* WI; const float* rope;
    __device__ __forceinline__ void operator()(const f32x4 (&acc)[2][2][4][2], const Unit& u, int wr, int wc, int fr, int fq) const {
        const int pn = u.pn; const int row0 = u.pm * BM + wr * 64 + fr, col0 = pn * BM + wc * 32 + 8 * fq;
        const bool is_gelu = pn < 4, is_rope_tile = (pn >= 4 && pn < 8) || pn == 10 || pn == 11;
        const bool rope_wave = is_rope_tile && ((wc & 1) == 0);
#pragma unroll
        for (int ai = 0; ai < 2; ++ai)
#pragma unroll
            for (int m = 0; m < 4; ++m) { const int row = row0 + ai * HALF + m * 16; bf16_t* rowp = P + (size_t)row * PROW + col0;
                f32x4 cs0, cs1, sn0, sn1;
                if (rope_wave) { const f32x4* rp = (const f32x4*)(rope + (size_t)row * 16); cs0 = rp[0]; cs1 = rp[1]; sn0 = rp[2]; sn1 = rp[3]; }
#pragma unroll
                for (int bj = 0; bj < 2; ++bj) { f32x4 v0 = acc[ai][bj][m][0], v1 = acc[ai][bj][m][1];
                    if (is_gelu) { f32x2 a = gelu_pk((f32x2){v0[0], v0[1]}), b = gelu_pk((f32x2){v0[2], v0[3]}), c = gelu_pk((f32x2){v1[0], v1[1]}), d = gelu_pk((f32x2){v1[2], v1[3]});
                        v0 = (f32x4){a.x, a.y, b.x, b.y}; v1 = (f32x4){c.x, c.y, d.x, d.y}; }
                    if (rope_wave && (pn != 11 || (bj == 0 && wc == 0))) {
                        f32x4 p0, p1;
#pragma unroll
                        for (int j = 0; j < 4; ++j) { p0[j] = __shfl_xor(v0[j], 16); p1[j] = __shfl_xor(v1[j], 16); }
                        if (fq == 0) { v0 = v0 * cs0 - p0 * sn0; v1 = v1 * cs1 - p1 * sn1; }
                        else if (fq == 1) { v0 = v0 * cs0 + p0 * sn0; v1 = v1 * cs1 + p1 * sn1; }
                    }
                    if (pn == 11 && bj == 0 && wc == 2 && fq == 0) *(f32x4*)(WI + (size_t)row * 4) = v0;
                    u32x4 w; w.x = cvt_pk_bf16(v0[0], v0[1]); w.y = cvt_pk_bf16(v0[2], v0[3]); w.z = cvt_pk_bf16(v1[0], v1[1]); w.w = cvt_pk_bf16(v1[2], v1[3]);
                    *(u32x4*)(rowp + bj * HALF) = w; } }
    }
};
template <class Epi, class Sched, bool ALIGN_EPI = false, bool SP2 = false>
__device__ __forceinline__ void gemm_phase(PG8_LAS unsigned char* lds, const Gemm g, const Sched& S, const Epi& E, const int tid) {
    const int wid = __builtin_amdgcn_readfirstlane(tid >> 6), lane = tid & 63, wr = wid >> 2, wc = wid & 3, fr = lane & 15, fq = lane >> 4;
    const int K = g.K, nt = K / BK;
    unsigned voffA[2], voffB[2];
#pragma unroll
    for (int i = 0; i < 2; ++i) { int R, C; stage_rc(tid * 16 + i * 8192, R, C); const int Rb = Epi::PERM ? ((R & ~31) + perm32(R & 31)) : R;
        voffA[i] = (unsigned)(R * K + C) * 2u; voffB[i] = (unsigned)(Rb * K + C) * 2u; }
    const size_t kstep = (size_t)(BK * 2);
    const size_t hstep = (size_t)HALF * K * 2;
    const size_t tstep = 2 * hstep;
    const unsigned ldsw = (unsigned)wid * 1024u;
    const int aoff = lds_byte(wr * 64 + fr, fq * 8), boff = lds_byte(wc * 32 + fr, fq * 8);
#define PG8_SA(b, h) (((b) * 2 + (h)) * HTB)
#define PG8_SB(b, h) ((4 + (b) * 2 + (h)) * HTB)
#define PG8_STAGE(bufoff, gbase, voff) do { _Pragma("unroll") for (int _i = 0; _i < 2; ++_i) \
        __builtin_amdgcn_global_load_lds((const unsigned*)((const char*)(gbase) + (voff)[_i]), (PG8_LAS unsigned*)(lds + (bufoff) + ldsw + _i * 8192), 16, 0, 0); } while (0)
#define PG8_LDA(dst, b, h) do { _Pragma("unroll") for (int m = 0; m < 4; ++m) _Pragma("unroll") for (int k = 0; k < 2; ++k) dst[m][k] = *(const PG8_LAS bf16x8*)(lds + PG8_SA(b, h) + aoff + m * 2048 + k * 1024); } while (0)
#define PG8_LDB(dst, b, h) do { _Pragma("unroll") for (int n = 0; n < 2; ++n) _Pragma("unroll") for (int k = 0; k < 2; ++k) dst[n][k] = *(const PG8_LAS bf16x8*)(lds + PG8_SB(b, h) + boff + n * 2048 + k * 1024); } while (0)
#define PG8_MMA(ai, bj, At, Bt) do { __builtin_amdgcn_s_setprio(1); _Pragma("unroll") for (int m = 0; m < 4; ++m) _Pragma("unroll") for (int n = 0; n < 2; ++n) _Pragma("unroll") for (int k = 0; k < 2; ++k) \
        acc[ai][bj][m][n] = __builtin_amdgcn_mfma_f32_16x16x32_bf16(Bt[n][k], At[m][k], acc[ai][bj][m][n], 0, 0, 0); __builtin_amdgcn_s_setprio(0); } while (0)
#define PG8_WAIT_V(n) asm volatile("s_waitcnt vmcnt(" #n ")" ::: "memory")
#define PG8_WAIT_L(n) asm volatile("s_waitcnt lgkmcnt(" #n ")" ::: "memory")
#define PG8_BAR __builtin_amdgcn_s_barrier()
#define PG8_SCHED __builtin_amdgcn_sched_barrier(0)
    Unit cur, nxt; int ui = 0;
    if (!S.next(0, cur)) return;
    f32x4 acc[2][2][4][2];
#pragma unroll
    for (int a = 0; a < 2; ++a)
#pragma unroll
        for (int b = 0; b < 2; ++b)
#pragma unroll
            for (int m = 0; m < 4; ++m)
#pragma unroll
                for (int n = 0; n < 2; ++n) acc[a][b][m][n] = (f32x4){0.f, 0.f, 0.f, 0.f};
    bf16x8 At[4][2], B0[2][2], B1[2][2];
    const char* cA = (const char*)g.A + (size_t)cur.pm * tstep; const char* cB = (const char*)g.Bt + (size_t)cur.pn * tstep;
    S.a_ready(cur);
    if constexpr (SP2) {
        PG8_STAGE(PG8_SB(0, 0), cB, voffB); PG8_STAGE(PG8_SB(0, 1), cB + hstep, voffB); PG8_STAGE(PG8_SA(0, 0), cA, voffA); PG8_STAGE(PG8_SA(0, 1), cA + hstep, voffA);
        if (wr == 1) PG8_BAR;
        PG8_WAIT_V(2); PG8_BAR;
        PG8_STAGE(PG8_SB(1, 0), cB + kstep, voffB); PG8_STAGE(PG8_SA(1, 0), cA + kstep, voffA); PG8_STAGE(PG8_SB(1, 1), cB + hstep + kstep, voffB);
        PG8_WAIT_V(6); PG8_BAR;
    } else {
        PG8_STAGE(PG8_SB(0, 0), cB, voffB); PG8_STAGE(PG8_SA(0, 0), cA, voffA); PG8_STAGE(PG8_SB(0, 1), cB + hstep, voffB); PG8_STAGE(PG8_SA(0, 1), cA + hstep, voffA);
        if (wr == 1) PG8_BAR;
        PG8_WAIT_V(4); PG8_BAR;
        PG8_STAGE(PG8_SB(1, 0), cB + kstep, voffB); PG8_STAGE(PG8_SA(1, 0), cA + kstep, voffA); PG8_STAGE(PG8_SB(1, 1), cB + hstep + kstep, voffB);
        PG8_WAIT_V(6); PG8_BAR;
    }
    for (;;) {
        const bool has_next = S.next(ui + 1, nxt);
        const char* nA = has_next ? (const char*)g.A + (size_t)nxt.pm * tstep : cA; const char* nB = has_next ? (const char*)g.Bt + (size_t)nxt.pn * tstep : cB;
        for (int t = 0; t < nt; t += 2) {
            const bool last = (t == nt - 2);
            const char* a1 = cA + (size_t)(t + 1) * kstep;
            const char* a2 = last ? nA : cA + (size_t)(t + 2) * kstep; const char* b2 = last ? nB : cB + (size_t)(t + 2) * kstep;
            const char* a3 = a2 + kstep; const char* b3 = b2 + kstep;
            if (last && has_next) S.a_ready(nxt);
            if constexpr (SP2) {
            PG8_LDB(B0, 0, 0); PG8_LDB(B1, 0, 1); PG8_SCHED; PG8_LDA(At, 0, 0); PG8_STAGE(PG8_SA(1, 1), a1 + hstep, voffA);
            PG8_WAIT_V(8); PG8_WAIT_L(0); PG8_BAR; PG8_MMA(0, 0, At, B0); PG8_MMA(0, 1, At, B1); PG8_BAR; PG8_SCHED;
            PG8_LDA(At, 0, 1); PG8_STAGE(PG8_SB(0, 0), b2, voffB); PG8_STAGE(PG8_SB(0, 1), b2 + hstep, voffB); PG8_STAGE(PG8_SA(0, 0), a2, voffA);
            PG8_WAIT_V(8); PG8_WAIT_L(0); PG8_BAR; PG8_MMA(1, 0, At, B0); PG8_MMA(1, 1, At, B1); PG8_BAR; PG8_SCHED;
            PG8_LDB(B0, 1, 0); PG8_LDB(B1, 1, 1); PG8_SCHED; PG8_LDA(At, 1, 0); PG8_STAGE(PG8_SA(0, 1), a2 + hstep, voffA);
            PG8_WAIT_V(8); PG8_WAIT_L(0); PG8_BAR; PG8_MMA(0, 0, At, B0); PG8_MMA(0, 1, At, B1); PG8_BAR; PG8_SCHED;
            PG8_LDA(At, 1, 1); PG8_STAGE(PG8_SB(1, 0), b3, voffB); PG8_STAGE(PG8_SB(1, 1), b3 + hstep, voffB); PG8_STAGE(PG8_SA(1, 0), a3, voffA);
            PG8_WAIT_V(8); PG8_WAIT_L(0); PG8_BAR; PG8_MMA(1, 0, At, B0); PG8_MMA(1, 1, At, B1); PG8_BAR; PG8_SCHED;
            } else {
            PG8_LDB(B0, 0, 0); PG8_SCHED; PG8_LDA(At, 0, 0); PG8_STAGE(PG8_SA(1, 1), a1 + hstep, voffA);
            PG8_WAIT_L(8); PG8_BAR; PG8_WAIT_L(0); PG8_MMA(0, 0, At, B0); PG8_BAR; PG8_SCHED;
            PG8_LDB(B1, 0, 1); PG8_STAGE(PG8_SB(0, 0), b2, voffB);
            PG8_BAR; PG8_WAIT_L(0); PG8_MMA(0, 1, At, B1); PG8_BAR;
            PG8_LDA(At, 0, 1); PG8_STAGE(PG8_SA(0, 0), a2, voffA);
            PG8_BAR; PG8_WAIT_L(0); PG8_MMA(1, 0, At, B0); PG8_BAR; PG8_SCHED;
            PG8_STAGE(PG8_SB(0, 1), b2 + hstep, voffB);
            PG8_WAIT_V(6); PG8_BAR; PG8_MMA(1, 1, At, B1); PG8_BAR;
            PG8_LDB(B0, 1, 0); PG8_SCHED; PG8_LDA(At, 1, 0); PG8_STAGE(PG8_SA(0, 1), a2 + hstep, voffA);
            PG8_WAIT_L(8); PG8_BAR; PG8_WAIT_L(0); PG8_MMA(0, 0, At, B0); PG8_BAR; PG8_SCHED;
            PG8_LDB(B1, 1, 1); PG8_STAGE(PG8_SB(1, 0), b3, voffB);
            PG8_BAR; PG8_WAIT_L(0); PG8_MMA(0, 1, At, B1); PG8_BAR;
            PG8_LDA(At, 1, 1); PG8_STAGE(PG8_SA(1, 0), a3, voffA);
            PG8_BAR; PG8_WAIT_L(0); PG8_MMA(1, 0, At, B0); PG8_BAR; PG8_SCHED;
            PG8_STAGE(PG8_SB(1, 1), b3 + hstep, voffB);
            PG8_WAIT_V(6); PG8_BAR; PG8_MMA(1, 1, At, B1); PG8_BAR;
            }
        }
        if constexpr (ALIGN_EPI) { if (wr == 0) PG8_BAR; }
        if constexpr (!Epi::AFTER_DRAIN) { E(acc, cur, wr, wc, fr, fq); S.done(cur); }
        if (!has_next) break;
#pragma unroll
        for (int a = 0; a < 2; ++a)
#pragma unroll
            for (int b = 0; b < 2; ++b)
#pragma unroll
                for (int m = 0; m < 4; ++m)
#pragma unroll
                    for (int n = 0; n < 2; ++n) acc[a][b][m][n] = (f32x4){0.f, 0.f, 0.f, 0.f};
        cur = nxt; cA = nA; cB = nB; ++ui;
        if constexpr (ALIGN_EPI) { if (wr == 1) PG8_BAR; }
    }
    PG8_WAIT_V(0);
    if constexpr (!ALIGN_EPI) { if (wr == 0) PG8_BAR; }
    PG8_BAR;
    if constexpr (Epi::AFTER_DRAIN) { E.fused(acc, cur, wr, wc, fr, fq, lds, wid, lane); S.done(cur); }
#undef PG8_SA
#undef PG8_SB
#undef PG8_STAGE
#undef PG8_LDA
#undef PG8_LDB
#undef PG8_MMA
#undef PG8_WAIT_V
#undef PG8_WAIT_L
#undef PG8_BAR
#undef PG8_SCHED
}
}

constexpr int NB = 8, SEQ = 2048, D = 1024, NL = 4, M = NB * SEQ, FF = 2816, FF2 = 2 * FF, PW = 2884, PWP = 3072, NMOD = 9 * D;
constexpr int NWAVES = 8, NTHR = 512;
typedef unsigned short bf16;
typedef unsigned v4u __attribute__((ext_vector_type(4)));
typedef unsigned v2u __attribute__((ext_vector_type(2)));
typedef float f32x4 __attribute__((ext_vector_type(4)));
typedef short bf16x8 __attribute__((ext_vector_type(8)));
typedef short bf16x4 __attribute__((ext_vector_type(4)));
typedef unsigned long long u64;
#define LAS __attribute__((address_space(3)))

constexpr size_t MiB = 1u << 20;
constexpr size_t WS_MOD = 1 * MiB;
constexpr size_t WS_ROPE = 3 * MiB;
constexpr size_t WS_WI = 4 * MiB;
constexpr size_t WS_SGUW = 5 * MiB;
constexpr size_t WS_MASK = 6 * MiB;
constexpr size_t WS_W = 16 * MiB, W_STRIDE = 42 * MiB;
constexpr size_t WO_1IN = 0, WO_1OUT = 11 * MiB, WO_MIX = 17 * MiB, WO_OUT = 23 * MiB, WO_2IN = 25 * MiB, WO_2OUT = 36 * MiB;
constexpr size_t WS_XN = 184 * MiB;
constexpr size_t WS_CAT = 216 * MiB;
constexpr size_t WS_BIG = 248 * MiB;
constexpr size_t WS_END = 344 * MiB;

struct Args {
    const float *x, *c; const int* pos; const float *ada_w, *ada_b, *norm_ffn1, *ffn1_w_in, *ffn1_w_out, *norm_mix, *mix_w_in, *sgu_w, *sgu_b, *mix_w_out, *norm_ffn2, *ffn2_w_in, *ffn2_w_out, *final_norm;
    float* out; unsigned char* ws;
};

__device__ __forceinline__ unsigned f2bf(float f) { unsigned u = __builtin_bit_cast(unsigned, f); return (u + 0x7fffu + ((u >> 16) & 1u)) >> 16; }
__device__ __forceinline__ unsigned pk2(float lo, float hi) { return f2bf(lo) | (f2bf(hi) << 16); }
__device__ __forceinline__ float wave_sum(float v) {
#pragma unroll
    for (int o = 1; o < 64; o <<= 1) v += __shfl_xor(v, o);
    return v;
}

__device__ __forceinline__ void p0_transpose_item(const float* W, int K, int N, bf16* WT, int mode, float* scr, int item, int nblk, int lane) {
    const int kb = item / nblk, nb = item % nblk, k0 = 64 * kb, n0 = 32 * nb;
    const int nsrc = n0 + (lane & 31); const bool ok = nsrc < N;
#pragma unroll 8
    for (int i = 0; i < 32; ++i) { const int kk = 2 * i + (lane >> 5); scr[kk * 33 + (lane & 31)] = ok ? W[(size_t)(k0 + kk) * N + nsrc] : 0.f; }
    asm volatile("s_waitcnt lgkmcnt(0)" ::: "memory");
    int d0 = n0;
    if (mode == 1) { const int j = n0 < FF ? n0 : n0 - FF; d0 = 256 * (j >> 7) + (j & 127) + (n0 < FF ? 0 : 128); }
    const int c = lane & 7;
#pragma unroll
    for (int j = 0; j < 4; ++j) { const int n = (lane >> 3) + 8 * j; const float* s = scr + (8 * c) * 33 + n;
        v4u o; o.x = pk2(s[0 * 33], s[1 * 33]); o.y = pk2(s[2 * 33], s[3 * 33]); o.z = pk2(s[4 * 33], s[5 * 33]); o.w = pk2(s[6 * 33], s[7 * 33]);
        *(v4u*)(WT + (size_t)(d0 + n) * K + k0 + 8 * c) = o; }
    asm volatile("s_waitcnt lgkmcnt(0)" ::: "memory");
}

__device__ __forceinline__ void p0_prologue(const Args& A, unsigned char* lds, int vcu, int G, int tid, int wave, int lane) {
    unsigned char* ws = A.ws;
    float* cact = (float*)lds;
    float* red = (float*)(lds + 32768);
    for (int i = tid; i < NB * D; i += NTHR) { const int b = i / D, k = i % D; const float v = A.c[i]; cact[k * 8 + b] = v / (1.0f + __expf(-v)); }
    __syncthreads();
    float* mod = (float*)(ws + WS_MOD);
    for (int it = vcu; it < NL * (NMOD / 64); it += G) {
        const int l = it / (NMOD / 64), n0 = (it % (NMOD / 64)) * 64;
        const float* wp = A.ada_w + (size_t)l * D * NMOD + (size_t)(128 * wave) * NMOD + n0 + lane;
        float acc[8];
#pragma unroll
        for (int b = 0; b < 8; ++b) acc[b] = 0.f;
#pragma unroll 8
        for (int k = 0; k < 128; ++k) { const float wv = wp[(size_t)k * NMOD]; const f32x4 c0 = *(const f32x4*)(cact + (128 * wave + k) * 8), c1 = *(const f32x4*)(cact + (128 * wave + k) * 8 + 4);
            acc[0] += c0[0] * wv; acc[1] += c0[1] * wv; acc[2] += c0[2] * wv; acc[3] += c0[3] * wv; acc[4] += c1[0] * wv; acc[5] += c1[1] * wv; acc[6] += c1[2] * wv; acc[7] += c1[3] * wv; }
#pragma unroll
        for (int b = 0; b < 8; ++b) red[(wave * 8 + b) * 64 + lane] = acc[b];
        __syncthreads();
        { const int b = tid >> 6, n = tid & 63; float s = A.ada_b[(size_t)l * NMOD + n0 + n];
#pragma unroll
          for (int w = 0; w < 8; ++w) s += red[(w * 8 + b) * 64 + n];
          mod[((size_t)l * NB + b) * NMOD + n0 + n] = s; }
        __syncthreads();
    }
    const int gt = vcu * NTHR + tid, NGT = G * NTHR;
    float* rope = (float*)(ws + WS_ROPE);
    for (int i = gt; i < M * 8; i += NGT) { const int m = i >> 3, f = i & 7; const float inv = exp2f(-(float)f * (0.125f * 18.931568569324174f));
        const float ang = (float)A.pos[m] * inv; const double rev = (double)ang * 0.15915494309189535; const float fr_ = (float)(rev - floor(rev));
        rope[m * 16 + f] = __builtin_amdgcn_cosf(fr_); rope[m * 16 + 8 + f] = __builtin_amdgcn_sinf(fr_); }
    bf16* sw = (bf16*)(ws + WS_SGUW);
    for (int i = gt; i < NL * 4 * 128 * 128; i += NGT) { const int s = i & 127, t = (i >> 7) & 127; sw[i] = (bf16)(s <= t ? f2bf(A.sgu_w[i]) : 0u); }
    float* scr = (float*)(lds + wave * 16384);
    const int gw = vcu * NWAVES + wave, NGW = G * NWAVES;
    constexpr int I_IN = (D / 64) * (FF2 / 32), I_OUT = (FF / 64) * (D / 32), I_MIX = (D / 64) * (PWP / 32), I_MO = (D / 64) * (D / 32);
    constexpr int I_LAYER = 2 * I_IN + 2 * I_OUT + I_MIX + I_MO;
    for (int it = gw; it < NL * I_LAYER; it += NGW) {
        const int l = it / I_LAYER; int r = it % I_LAYER; unsigned char* wl = ws + WS_W + (size_t)l * W_STRIDE;
        if (r < I_IN) { p0_transpose_item(A.ffn1_w_in + (size_t)l * D * FF2, D, FF2, (bf16*)(wl + WO_1IN), 1, scr, r, FF2 / 32, lane); continue; } r -= I_IN;
        if (r < I_IN) { p0_transpose_item(A.ffn2_w_in + (size_t)l * D * FF2, D, FF2, (bf16*)(wl + WO_2IN), 1, scr, r, FF2 / 32, lane); continue; } r -= I_IN;
        if (r < I_OUT) { p0_transpose_item(A.ffn1_w_out + (size_t)l * FF * D, FF, D, (bf16*)(wl + WO_1OUT), 0, scr, r, D / 32, lane); continue; } r -= I_OUT;
        if (r < I_OUT) { p0_transpose_item(A.ffn2_w_out + (size_t)l * FF * D, FF, D, (bf16*)(wl + WO_2OUT), 0, scr, r, D / 32, lane); continue; } r -= I_OUT;
        if (r < I_MIX) { p0_transpose_item(A.mix_w_in + (size_t)l * D * PW, D, PW, (bf16*)(wl + WO_MIX), 0, scr, r, PWP / 32, lane); continue; } r -= I_MIX;
        p0_transpose_item(A.mix_w_out + (size_t)l * D * D, D, D, (bf16*)(wl + WO_OUT), 0, scr, r, D / 32, lane);
    }
}

__device__ __forceinline__ void norm_mod_phase(const float* x, const float* g, const float* shift, const float* scale, bf16* XN, int vcu, int G, int wave, int lane) {
    const int gw = vcu * NWAVES + wave, NGW = G * NWAVES;
    for (int blk = gw; blk < M / 8; blk += NGW) {
        const int m0 = blk * 8, b = m0 / SEQ;
        f32x4 gm[4], sh[4];
#pragma unroll
        for (int j = 0; j < 4; ++j) { const int k = 4 * lane + 256 * j; gm[j] = *(const f32x4*)(g + k) * (*(const f32x4*)(scale + (size_t)b * NMOD + k) + 1.0f); sh[j] = *(const f32x4*)(shift + (size_t)b * NMOD + k); }
        for (int r = 0; r < 8; ++r) {
            const float* xr = x + (size_t)(m0 + r) * D; f32x4 v[4]; float s = 0.f;
#pragma unroll
            for (int j = 0; j < 4; ++j) { v[j] = *(const f32x4*)(xr + 4 * lane + 256 * j); s += (v[j][0] * v[j][0] + v[j][1] * v[j][1]) + (v[j][2] * v[j][2] + v[j][3] * v[j][3]); }
            const float rstd = 1.0f / sqrtf(wave_sum(s) * (1.0f / D) + 1e-6f);
            bf16* orow = XN + (size_t)(m0 + r) * D;
#pragma unroll
            for (int j = 0; j < 4; ++j) { const f32x4 o = v[j] * rstd * gm[j] + sh[j]; v2u w; w.x = pk2(o[0], o[1]); w.y = pk2(o[2], o[3]); *(v2u*)(orow + 4 * lane + 256 * j) = w; }
        }
    }
}
__device__ __forceinline__ void final_norm_phase(float* x, const float* g, int vcu, int G, int wave, int lane) {
    const int gw = vcu * NWAVES + wave, NGW = G * NWAVES;
    f32x4 gm[4];
#pragma unroll
    for (int j = 0; j < 4; ++j) gm[j] = *(const f32x4*)(g + 4 * lane + 256 * j);
    for (int m = gw; m < M; m += NGW) {
        float* xr = x + (size_t)m * D; f32x4 v[4]; float s = 0.f;
#pragma unroll
        for (int j = 0; j < 4; ++j) { v[j] = *(const f32x4*)(xr + 4 * lane + 256 * j); s += (v[j][0] * v[j][0] + v[j][1] * v[j][1]) + (v[j][2] * v[j][2] + v[j][3] * v[j][3]); }
        const float rstd = 1.0f / sqrtf(wave_sum(s) * (1.0f / D) + 1e-6f);
#pragma unroll
        for (int j = 0; j < 4; ++j) *(f32x4*)(xr + 4 * lane + 256 * j) = v[j] * rstd * gm[j];
    }
}

constexpr int SGU_PITCH = 260;
__device__ __forceinline__ void sgu_item(const bf16* P, const bf16* sw  , const float* sb  , bf16* CAT, unsigned char* lds, int item, int tid, int wave, int lane) {
    const int g = item & 3, ch = (item >> 2) & 15, b = item >> 6; const int fr = lane & 15, fq = lane >> 4;
    const size_t tok0 = (size_t)b * SEQ + ch * 128;
    __syncthreads();
#pragma unroll
    for (int i = 0; i < 4; ++i) { const int p = tid + i * NTHR, row = p >> 4, cc = p & 15; const v4u v = *(const v4u*)(P + (tok0 + row) * pg8::PROW + 512 + g * 128 + cc * 8);
        unsigned* d = (unsigned*)(lds + row * SGU_PITCH + cc * 16); d[0] = v.x; d[1] = v.y; d[2] = v.z; d[3] = v.w; }
    __syncthreads();
    bf16x8 yf[4];
#pragma unroll
    for (int ks = 0; ks < 4; ++ks)
#pragma unroll
        for (int j = 0; j < 8; ++j) yf[ks][j] = (short)*(const unsigned short*)(lds + (32 * ks + 8 * fq + j) * SGU_PITCH + (16 * wave + fr) * 2);
    const bf16* wg = sw + (size_t)g * 128 * 128;
#pragma unroll
    for (int tt = 0; tt < 8; ++tt) {
        f32x4 acc = (f32x4){0.f, 0.f, 0.f, 0.f};
#pragma unroll
        for (int ks = 0; ks <= tt / 2; ++ks) { const bf16x8 xf = *(const bf16x8*)(wg + (size_t)(16 * tt + fr) * 128 + 32 * ks + 8 * fq); acc = __builtin_amdgcn_mfma_f32_16x16x32_bf16(xf, yf[ks], acc, 0, 0, 0); }
        const int c = 128 * g + 16 * wave + fr;
#pragma unroll
        for (int ii = 0; ii < 4; ++ii) { const int t = 16 * tt + 4 * fq + ii; const size_t tok = tok0 + t;
            const float uu = __uint_as_float((unsigned)P[tok * pg8::PROW + c] << 16);
            CAT[tok * D + c] = (bf16)f2bf((acc[ii] + sb[g * 128 + t]) * uu); }
    }
}

constexpr int KI_PITCH = 144, KI_TILE = 128 * KI_PITCH;
__device__ __forceinline__ u64 causal_bits(int t, int k) { const int n = t - 64 * k + 1; return n >= 64 ? ~0ull : (n <= 0 ? 0ull : ((1ull << n) - 1ull)); }
__device__ __forceinline__ unsigned grp_sum16(unsigned v) { v += __shfl_xor(v, 1); v += __shfl_xor(v, 2); v += __shfl_xor(v, 4); v += __shfl_xor(v, 8); return v; }
__device__ __forceinline__ void indexer_item(const bf16* P, const float* WI, u64* MASK, unsigned char* lds, int b, int j, int tid, int wave, int lane) {
    const int fr = lane & 15, fq = lane >> 4; const int t_own = 32 * j + 4 * wave + fq; const int nt = j / 4 + 1;
    u64* mrow = MASK + ((size_t)b * SEQ + t_own) * 32;
    if (j < 8) {
        for (int k = fr; k < 2 * nt; k += 16) mrow[k] = causal_bits(t_own, k);
        return;
    }
    const bf16* Pb = P + (size_t)b * SEQ * pg8::PROW;
    bf16x8 xq0, xq1;
    { const bf16* qp = Pb + (size_t)(32 * j + 4 * wave + (fr >> 2)) * pg8::PROW + 2560 + (fr & 3) * 64 + 8 * fq; xq0 = *(const bf16x8*)qp; xq1 = *(const bf16x8*)(qp + 32); }
    const f32x4 wv = *(const f32x4*)(WI + ((size_t)b * SEQ + t_own) * 4);
    unsigned sk[128]; const int rel = t_own - fr;
    const bf16* kisrc = Pb + 2816;
    v4u st0, st1;
    const bf16* kp0 = kisrc + (size_t)(tid >> 3) * pg8::PROW + (tid & 7) * 8; const bf16* kp1 = kisrc + (size_t)((tid + NTHR) >> 3) * pg8::PROW + (tid & 7) * 8;
#define KI_LOAD(tile) do { st0 = *(const v4u*)kp0; st1 = *(const v4u*)kp1; kp0 += 128 * pg8::PROW; kp1 += 128 * pg8::PROW; asm volatile("" : "+v"(kp0), "+v"(kp1)); } while (0)
#define KI_STORE(buf) do { const int p0_ = tid, p1_ = tid + NTHR; *(v4u*)(lds + (buf) * KI_TILE + (p0_ >> 3) * KI_PITCH + (p0_ & 7) * 16) = st0; *(v4u*)(lds + (buf) * KI_TILE + (p1_ >> 3) * KI_PITCH + (p1_ & 7) * 16) = st1; } while (0)
    __syncthreads();
    KI_LOAD(0); KI_STORE(0);
    __syncthreads();
#pragma unroll
    for (int tile = 0; tile < 16; ++tile) {
        {
            if (tile + 1 < 16) KI_LOAD(tile + 1);
            const unsigned char* kb = lds + (tile & 1) * KI_TILE;
#pragma unroll
            for (int nb = 0; nb < 8; ++nb) {
                const bf16x8 y0 = *(const bf16x8*)(kb + (16 * nb + fr) * KI_PITCH + 16 * fq), y1 = *(const bf16x8*)(kb + (16 * nb + fr) * KI_PITCH + 16 * fq + 64);
                f32x4 a = __builtin_amdgcn_mfma_f32_16x16x32_bf16(xq0, y0, (f32x4){0.f, 0.f, 0.f, 0.f}, 0, 0, 0);
                a = __builtin_amdgcn_mfma_f32_16x16x32_bf16(xq1, y1, a, 0, 0, 0);
                float sc = wv[0] * fmaxf(a[0], 0.f) + wv[1] * fmaxf(a[1], 0.f) + wv[2] * fmaxf(a[2], 0.f) + wv[3] * fmaxf(a[3], 0.f);
                sc = (sc == 0.f) ? 0.f : sc;
                const unsigned ub = __float_as_uint(sc); unsigned key = ub ^ ((unsigned)((int)ub >> 31) | 0x80000000u);
                sk[tile * 8 + nb] = (rel >= 128 * tile + 16 * nb) ? key : 0u;
                __builtin_amdgcn_sched_barrier(0);
            }
            if (tile + 1 < 16) KI_STORE((tile + 1) & 1);
            __syncthreads();
        }
    }
#undef KI_LOAD
#undef KI_STORE
    unsigned T = 0u, cntT = 4096u;
    for (int bit = 31; bit >= 0; --bit) {
        const unsigned cand = T | (1u << bit); unsigned c = 0u;
#pragma unroll
        for (int tile = 0; tile < 16; ++tile) if (tile < nt) {
#pragma unroll
            for (int nb = 0; nb < 8; ++nb) c += (sk[tile * 8 + nb] >= cand) ? 1u : 0u; }
        c = grp_sum16(c);
        if (c >= 256u) { T = cand; cntT = c; }
        if (__all(cntT == 256u)) break;
    }
    const bool tie_any = __any(cntT != 256u);
    unsigned need = 0u, running = 0u;
    if (tie_any) { unsigned c = 0u;
#pragma unroll
        for (int tile = 0; tile < 16; ++tile) if (tile < nt) {
#pragma unroll
            for (int nb = 0; nb < 8; ++nb) c += (sk[tile * 8 + nb] > T) ? 1u : 0u; }
        c = grp_sum16(c); need = 256u - c; }
    u64 word = 0ull;
#pragma unroll
    for (int tile = 0; tile < 16; ++tile) if (tile < nt) {
#pragma unroll
        for (int nb = 0; nb < 8; ++nb) { const int r = tile * 8 + nb; const unsigned v = sk[r]; bool sel;
            if (tie_any) { const bool eq = (v == T); const u64 be = __ballot(eq); const unsigned pe = (unsigned)(be >> (16 * fq)) & 0xFFFFu;
                const unsigned before = running + __popc(pe & ((1u << fr) - 1u)); sel = (v > T) || (eq && before < need); running += __popc(pe); }
            else sel = v >= T;
            const u64 bs = __ballot(sel); const unsigned ps = (unsigned)(bs >> (16 * fq)) & 0xFFFFu;
            word |= (u64)ps << (16 * (r & 3));
            if ((r & 3) == 3) { if (fr == 0) mrow[r >> 2] = word; word = 0ull; } } }
}

constexpr int AT_PITCH = 144, AT_TILE = 64 * AT_PITCH;
__device__ __forceinline__ void attn_unit(const bf16* P, const u64* MASK, bf16* CAT, unsigned char* lds, int b, int h, int qb, int tid, int wave, int lane) {
    const int fr = lane & 15, fq = lane >> 4; const int q0 = 128 * qb + 16 * wave;
    const bf16* Pb = P + (size_t)b * SEQ * pg8::PROW;
    bf16x8 qf0, qf1;
    { const bf16* qp = Pb + (size_t)(q0 + fr) * pg8::PROW + 1024 + h * 64 + 8 * fq; qf0 = *(const bf16x8*)qp; qf1 = *(const bf16x8*)(qp + 32); }
    const u64* mrow = MASK + ((size_t)b * SEQ + q0 + fr) * 32;
    f32x4 o[4];
#pragma unroll
    for (int i = 0; i < 4; ++i) o[i] = (f32x4){0.f, 0.f, 0.f, 0.f};
    float mrun = -1e30f, lrun = 0.f;
    const int NT = 2 * (qb + 1);
    const int kkey = tid >> 3, kch = tid & 7, vkey = tid & 63, vch = tid >> 6;
    const bf16* ksrc = Pb + (size_t)kkey * pg8::PROW + 1536 + h * 64 + kch * 8;
    const bf16* vsrc = Pb + (size_t)vkey * pg8::PROW + 2048 + h * 64 + vch * 8;
    v4u kreg, vreg;
#define AT_LOAD(t) do { kreg = *(const v4u*)(ksrc + (size_t)(64 * (t)) * pg8::PROW); vreg = *(const v4u*)(vsrc + (size_t)(64 * (t)) * pg8::PROW); } while (0)
#define AT_STORE(buf) do { *(v4u*)(lds + (buf) * AT_TILE + kkey * AT_PITCH + kch * 16) = kreg; \
        unsigned short* vd_ = (unsigned short*)(lds + (2 + (buf)) * AT_TILE + (vch * 8) * AT_PITCH + vkey * 2); \
        vd_[0] = (unsigned short)vreg.x; vd_[AT_PITCH / 2] = (unsigned short)(vreg.x >> 16); vd_[2 * (AT_PITCH / 2)] = (unsigned short)vreg.y; vd_[3 * (AT_PITCH / 2)] = (unsigned short)(vreg.y >> 16); \
        vd_[4 * (AT_PITCH / 2)] = (unsigned short)vreg.z; vd_[5 * (AT_PITCH / 2)] = (unsigned short)(vreg.z >> 16); vd_[6 * (AT_PITCH / 2)] = (unsigned short)vreg.w; vd_[7 * (AT_PITCH / 2)] = (unsigned short)(vreg.w >> 16); } while (0)
    __syncthreads();
    AT_LOAD(0); AT_STORE(0);
    __syncthreads();
    const float CS = 0.125f * 1.4426950408889634f;
    for (int t = 0; t < (ATT_TRIVIAL ? 0 : NT); ++t) {
        if (t + 1 < NT) AT_LOAD(t + 1);
        const u64 mw = (ATT_IGNORE_MASK ? causal_bits(q0 + fr, t) : mrow[t]) >> (4 * fq);
        const unsigned mlo = (unsigned)mw, mhi = (unsigned)(mw >> 32);
        const unsigned char* kb = lds + (t & 1) * AT_TILE; const unsigned char* vb = lds + (2 + (t & 1)) * AT_TILE;
        f32x4 s[4];
#pragma unroll
        for (int nb = 0; nb < 4; ++nb) {
            const bf16x8 k0 = *(const bf16x8*)(kb + (16 * nb + fr) * AT_PITCH + 16 * fq), k1 = *(const bf16x8*)(kb + (16 * nb + fr) * AT_PITCH + 16 * fq + 64);
            s[nb] = __builtin_amdgcn_mfma_f32_16x16x32_bf16(k0, qf0, (f32x4){0.f, 0.f, 0.f, 0.f}, 0, 0, 0);
            s[nb] = __builtin_amdgcn_mfma_f32_16x16x32_bf16(k1, qf1, s[nb], 0, 0, 0);
        }
        float tmax = -1e30f;
#pragma unroll
        for (int nb = 0; nb < 4; ++nb) { const unsigned mbits = ((nb & 2) ? mhi : mlo) >> (16 * (nb & 1));
#pragma unroll
            for (int ii = 0; ii < 4; ++ii) { const float v = ((mbits >> ii) & 1u) ? s[nb][ii] * CS : -1e30f; s[nb][ii] = v; tmax = fmaxf(tmax, v); } }
        tmax = fmaxf(tmax, __shfl_xor(tmax, 16)); tmax = fmaxf(tmax, __shfl_xor(tmax, 32));
        const float mnew = fmaxf(mrun, tmax), alpha = __builtin_amdgcn_exp2f(mrun - mnew); mrun = mnew;
        float psum = 0.f;
#pragma unroll
        for (int nb = 0; nb < 4; ++nb)
#pragma unroll
            for (int ii = 0; ii < 4; ++ii) { const float p = __builtin_amdgcn_exp2f(s[nb][ii] - mnew); s[nb][ii] = p; psum += p; }
        lrun = lrun * alpha + psum;
#pragma unroll
        for (int i = 0; i < 4; ++i) o[i] = o[i] * alpha;
        bf16x8 pk[2];
#pragma unroll
        for (int ss = 0; ss < 2; ++ss) { v4u w; w.x = pg8::cvt_pk_bf16(s[2 * ss][0], s[2 * ss][1]); w.y = pg8::cvt_pk_bf16(s[2 * ss][2], s[2 * ss][3]); w.z = pg8::cvt_pk_bf16(s[2 * ss + 1][0], s[2 * ss + 1][1]); w.w = pg8::cvt_pk_bf16(s[2 * ss + 1][2], s[2 * ss + 1][3]);
            pk[ss] = __builtin_bit_cast(bf16x8, w); }
#pragma unroll
        for (int db = 0; db < 4; ++db)
#pragma unroll
            for (int ss = 0; ss < 2; ++ss) { const unsigned char* vp = vb + (16 * db + fr) * AT_PITCH + (32 * ss + 4 * fq) * 2;
                const v2u a0 = *(const v2u*)vp, a1 = *(const v2u*)(vp + 32); v4u aw; aw.x = a0.x; aw.y = a0.y; aw.z = a1.x; aw.w = a1.y;
                o[db] = __builtin_amdgcn_mfma_f32_16x16x32_bf16(__builtin_bit_cast(bf16x8, aw), pk[ss], o[db], 0, 0, 0); }
        if (t + 1 < NT) AT_STORE((t + 1) & 1);
        __syncthreads();
    }
#undef AT_LOAD
#undef AT_STORE
    lrun += __shfl_xor(lrun, 16); lrun += __shfl_xor(lrun, 32);
    const float inv = ATT_TRIVIAL ? 1.0f : 1.0f / lrun; if (ATT_TRIVIAL) { for (int i = 0; i < 4; ++i) o[i] = (f32x4){0.01f * fr, 0.02f * fq, 0.001f * (float)qf0[0], 0.5f}; }
    bf16* orow = CAT + ((size_t)b * SEQ + q0 + fr) * D + 512 + h * 64 + 4 * fq;
#pragma unroll
    for (int db = 0; db < 4; ++db) { v2u w; w.x = pg8::cvt_pk_bf16(o[db][0] * inv, o[db][1] * inv); w.y = pg8::cvt_pk_bf16(o[db][2] * inv, o[db][3] * inv); *(v2u*)(orow + 16 * db) = w; }
}

#ifndef PHM
#define PHM 0xFFFF
#endif
constexpr int LDS_BYTES = 147456;
__global__ void __launch_bounds__(NTHR, 2) mega_fwd(Args A) {
    extern __shared__ __attribute__((aligned(16))) unsigned char lds[];
    cg::grid_group grid = cg::this_grid();
#define GSYNC() do { asm volatile("s_waitcnt vmcnt(0) lgkmcnt(0)" ::: "memory"); grid.sync(); __builtin_amdgcn_fence(__ATOMIC_ACQUIRE, "agent"); asm volatile("s_waitcnt vmcnt(0)" ::: "memory"); } while (0)
    const int tid = threadIdx.x, lane = tid & 63, wave = __builtin_amdgcn_readfirstlane(tid >> 6);
    const int G = gridDim.x, bx = blockIdx.x; const int vcu = (G % 8 == 0) ? (bx % 8) * (G / 8) + bx / 8 : bx;
    unsigned char* ws = A.ws;
    PG8_LAS unsigned char* lds3 = (PG8_LAS unsigned char*)lds;
    float* xres = A.out;
    const float* mod = (const float*)(ws + WS_MOD); const float* rope = (const float*)(ws + WS_ROPE); float* WI = (float*)(ws + WS_WI);
    u64* MASK = (u64*)(ws + WS_MASK); bf16* XN = (bf16*)(ws + WS_XN); bf16* CAT = (bf16*)(ws + WS_CAT); bf16* BIG = (bf16*)(ws + WS_BIG);

    if (PHM & 1) p0_prologue(A, lds, vcu, G, tid, wave, lane);
    GSYNC();
    for (int l = 0; l < NL; ++l) {
        int tid_o = tid, lane_o, wave_o;
#define OPQ() do { tid_o = tid; asm volatile("" : "+v"(tid_o)); lane_o = tid_o & 63; wave_o = __builtin_amdgcn_readfirstlane(tid_o >> 6); } while (0)
        OPQ();
        const float* modl = mod + (size_t)l * NB * NMOD; unsigned char* wl = ws + WS_W + (size_t)l * W_STRIDE;
        const float* xin = (l == 0) ? A.x : xres;
        if (PHM & 2) norm_mod_phase(xin, A.norm_ffn1 + l * D, modl + 0 * D, modl + 1 * D, XN, vcu, G, wave_o, lane_o);
        GSYNC();
        OPQ();
        if (PHM & 4) { pg8::Gemm g{XN, (const bf16*)(wl + WO_1IN), M, FF2, D}; pg8::StaticOrder S; S.init(M, FF2, G, bx); pg8::EpiSwiGLU E{BIG, FF};
          pg8::gemm_phase<pg8::EpiSwiGLU, pg8::StaticOrder, true, true>(lds3, g, S, E, tid_o); }
        GSYNC();
        OPQ();
        if (PHM & 8) { pg8::Gemm g{BIG, (const bf16*)(wl + WO_1OUT), M, D, FF}; pg8::StaticOrder S; S.init(M, D, G, bx); pg8::EpiResid E{xin, xres, modl + 2 * D, NMOD, 0.5f};
          pg8::gemm_phase<pg8::EpiResid, pg8::StaticOrder, true, true>(lds3, g, S, E, tid_o); }
        GSYNC();
        OPQ();
        if (PHM & 2) norm_mod_phase(xres, A.norm_mix + l * D, modl + 3 * D, modl + 4 * D, XN, vcu, G, wave_o, lane_o);
        GSYNC();
        OPQ();
        if (PHM & 16) { pg8::Gemm g{XN, (const bf16*)(wl + WO_MIX), M, PWP, D}; pg8::StaticOrder S; S.init(M, PWP, G, bx); pg8::EpiProj E{BIG, WI, rope};
          pg8::gemm_phase<pg8::EpiProj, pg8::StaticOrder, true, true>(lds3, g, S, E, tid_o); }
        GSYNC();
        OPQ();
        {
          if (PHM & 32) for (int it = vcu; it < NB * 32; it += G) { const int b = it >> 5, s = it & 31;
              for (int rep = 0; rep < 2; ++rep) indexer_item(BIG, WI, MASK, lds, b, rep ? 63 - s : s, tid_o, wave_o, lane_o); }
          const bf16* sw = (const bf16*)(ws + WS_SGUW) + (size_t)l * 4 * 128 * 128; const float* sb = A.sgu_b + (size_t)l * 4 * 128;
          if (PHM & 64) for (int it = vcu; it < NB * 16 * 4; it += G) sgu_item(BIG, sw, sb, CAT, lds, it, tid_o, wave_o, lane_o);
        }
        GSYNC();
        OPQ();
        if (PHM & 128) { for (int it = vcu; it < NB * 8 * 4; it += G) { const int bh = it >> 2, s = it & 3; const int b = bh >> 3, h = bh & 7;
              attn_unit(BIG, MASK, CAT, lds, b, h, 15 - s, tid_o, wave_o, lane_o); attn_unit(BIG, MASK, CAT, lds, b, h, s, tid_o, wave_o, lane_o);
              attn_unit(BIG, MASK, CAT, lds, b, h, 8 + s, tid_o, wave_o, lane_o); attn_unit(BIG, MASK, CAT, lds, b, h, 7 - s, tid_o, wave_o, lane_o); } }
        GSYNC();
        OPQ();
        if (PHM & 256) { pg8::Gemm g{CAT, (const bf16*)(wl + WO_OUT), M, D, D}; pg8::StaticOrder S; S.init(M, D, G, bx); pg8::EpiResid E{xres, xres, modl + 5 * D, NMOD, 1.0f};
          pg8::gemm_phase<pg8::EpiResid, pg8::StaticOrder, true, true>(lds3, g, S, E, tid_o); }
        GSYNC();
        OPQ();
        if (PHM & 2) norm_mod_phase(xres, A.norm_ffn2 + l * D, modl + 6 * D, modl + 7 * D, XN, vcu, G, wave_o, lane_o);
        GSYNC();
        OPQ();
        if (PHM & 512) { pg8::Gemm g{XN, (const bf16*)(wl + WO_2IN), M, FF2, D}; pg8::StaticOrder S; S.init(M, FF2, G, bx); pg8::EpiSwiGLU E{BIG, FF};
          pg8::gemm_phase<pg8::EpiSwiGLU, pg8::StaticOrder, true, true>(lds3, g, S, E, tid_o); }
        GSYNC();
        OPQ();
        if (PHM & 1024) { pg8::Gemm g{BIG, (const bf16*)(wl + WO_2OUT), M, D, FF}; pg8::StaticOrder S; S.init(M, D, G, bx); pg8::EpiResid E{xres, xres, modl + 8 * D, NMOD, 0.5f};
          pg8::gemm_phase<pg8::EpiResid, pg8::StaticOrder, true, true>(lds3, g, S, E, tid_o); }
        GSYNC();
        OPQ();
    }
    if (PHM & 2048) final_norm_phase(xres, A.final_norm, vcu, G, wave, lane);
}

extern "C" void kernel_launch(void* const* d_in, const int* in_sizes, int n_in, void* d_out, int out_size, void* d_ws, size_t ws_size, hipStream_t stream) {
    static int grid = 0;
    if (grid == 0) {
        if (n_in != 17 || in_sizes[0] != M * D || out_size != M * D || ws_size < WS_END) { fprintf(stderr, "kernel_launch: unexpected shapes/workspace (n_in %d, in0 %d, out %d, ws %zu, need %zu)\n", n_in, n_in > 0 ? in_sizes[0] : -1, out_size, ws_size, (size_t)WS_END); grid = -1; return; }
        int dev = 0, cus = 0, per_cu = 0;
        (void)hipGetDevice(&dev); (void)hipDeviceGetAttribute(&cus, hipDeviceAttributeMultiprocessorCount, dev);
        if (hipFuncSetAttribute((const void*)mega_fwd, hipFuncAttributeMaxDynamicSharedMemorySize, LDS_BYTES) != hipSuccess) { fprintf(stderr, "kernel_launch: hipFuncSetAttribute failed\n"); grid = -1; return; }
        if (hipOccupancyMaxActiveBlocksPerMultiprocessor(&per_cu, (const void*)mega_fwd, NTHR, LDS_BYTES) != hipSuccess || per_cu < 1) { fprintf(stderr, "kernel_launch: occupancy query gave %d\n", per_cu); per_cu = 1; }
        (void)hipGetLastError();
        grid = cus * per_cu;
    }
    if (grid < 0) return;
    Args a{};
    a.x = (const float*)d_in[0]; a.c = (const float*)d_in[1]; a.pos = (const int*)d_in[2]; a.ada_w = (const float*)d_in[3]; a.ada_b = (const float*)d_in[4];
    a.norm_ffn1 = (const float*)d_in[5]; a.ffn1_w_in = (const float*)d_in[6]; a.ffn1_w_out = (const float*)d_in[7]; a.norm_mix = (const float*)d_in[8]; a.mix_w_in = (const float*)d_in[9];
    a.sgu_w = (const float*)d_in[10]; a.sgu_b = (const float*)d_in[11]; a.mix_w_out = (const float*)d_in[12]; a.norm_ffn2 = (const float*)d_in[13]; a.ffn2_w_in = (const float*)d_in[14];
    a.ffn2_w_out = (const float*)d_in[15]; a.final_norm = (const float*)d_in[16]; a.out = (float*)d_out; a.ws = (unsigned char*)d_ws;
    void* args[] = {&a};
    hipError_t e = hipLaunchCooperativeKernel((const void*)mega_fwd, dim3(grid), dim3(NTHR), args, LDS_BYTES, stream);
    if (e != hipSuccess) fprintf(stderr, "kernel_launch: cooperative launch failed: %s (grid %d)\n", hipGetErrorString(e), grid);
}
```

```cpp
#include <hip/hip_runtime.h>
#include <hip/hip_cooperative_groups.h>
#include <cstdio>
#include <cstdint>
namespace cg = cooperative_groups;
#ifndef R_SYNC
#define R_SYNC 1
#endif
#ifndef R_MIX
#define R_MIX 1
#endif
#ifndef R_NORM
#define R_NORM 1
#endif
#ifndef R_P0
#define R_P0 1
#endif
#ifndef ATT_TRIVIAL
#define ATT_TRIVIAL 0
#endif
#ifndef ATT_IGNORE_MASK
#define ATT_IGNORE_MASK 0
#endif
namespace pg8 {
#define PG8_LAS __attribute__((address_space(3)))
typedef unsigned short bf16_t;
typedef short bf16x8 __attribute__((ext_vector_type(8)));
typedef float f32x4 __attribute__((ext_vector_type(4)));
typedef unsigned u32x4 __attribute__((ext_vector_type(4)));
constexpr int BM = 256, BK = 64, HALF = 128, HTB = HALF * BK * 2  , STAGE_BYTES = 8 * HTB, NXCD = 8, WGM = 8;

__host__ __device__ __forceinline__ int lds_byte(int r, int c) { const int st = (r >> 4) * 2 + (c >> 5), rr = r & 15, cc = c & 31, ob = rr * 64 + cc * 2; return st * 1024 + (ob ^ (((ob >> 9) & 1) << 5)); }
__host__ __device__ __forceinline__ void stage_rc(int b, int& R, int& C) { const int st = b / 1024, sb = b % 1024, swz = sb ^ (((sb >> 9) & 1) << 5); R = (st >> 1) * 16 + swz / 64; C = (st & 1) * 32 + (swz % 64) / 2; }
__host__ __device__ __forceinline__ int perm32(int rho) { const int n = rho >> 4, i = rho & 15; return 8 * (i >> 2) + 4 * n + (i & 3); }

struct Unit { int pm, pn; };
struct Gemm { const bf16_t* A; const bf16_t* Bt; int M, N, K; };

struct StaticOrder {
    int nM, nN, nwg, G, c;
    __host__ __device__ void init(int M, int N, int G_, int c_) { nM = M / BM; nN = N / BM; nwg = nM * nN; G = G_; c = c_; }
    __host__ __device__ bool next(int i, Unit& u) const {
        const long L = (long)i * G + c; if (L >= nwg) return false;
        int wgid = (int)L; { const int q = nwg / NXCD, r = nwg % NXCD, xcd = wgid % NXCD, off = wgid / NXCD; wgid = (xcd < r ? xcd * (q + 1) : r * (q + 1) + (xcd - r) * q) + off; }
        const int nig = WGM * nN, gid = wgid / nig, fm = gid * WGM, gsz = (nM - fm) < WGM ? (nM - fm) : WGM;
        u.pm = fm + ((wgid % nig) % gsz); u.pn = (wgid % nig) / gsz; return true;
    }
    __device__ __forceinline__ void a_ready(const Unit&) const {}
    __device__ __forceinline__ void done(const Unit&) const {}
};

typedef float f32x2_t __attribute__((ext_vector_type(2))); typedef __bf16 bf16x2_t __attribute__((ext_vector_type(2)));
__device__ __forceinline__ unsigned cvt_pk_bf16(float lo, float hi) { f32x2_t v = {lo, hi}; bf16x2_t b = __builtin_convertvector(v, bf16x2_t); return __builtin_bit_cast(unsigned, b); }
typedef float f32x2 __attribute__((ext_vector_type(2)));
__device__ __forceinline__ f32x2 gelu_pk(f32x2 v) {
    const f32x2 av = __builtin_elementwise_abs(v), d = av * 0.2316418882f + 1.0f;
    f32x2 t; t.x = __builtin_amdgcn_rcpf(d.x); t.y = __builtin_amdgcn_rcpf(d.y);
    f32x2 q = t * 0.5307027145f + (-0.7265760135f); q = q * t + 0.7107068705f; q = q * t + (-0.142248368f); q = q * t + 0.127414796f; q = q * t;
    const f32x2 s = (v * v) * (-0.72134752044f);
    f32x2 e; e.x = __builtin_amdgcn_exp2f(s.x); e.y = __builtin_amdgcn_exp2f(s.y);
    const f32x2 m = v * (q * e), r = v - m;
    f32x2 o; o.x = v.x < 0.f ? m.x : r.x; o.y = v.y < 0.f ? m.y : r.y; return o;
}


constexpr int PROW = 3072;
__device__ __forceinline__ float silu_f(float g) { return g * __builtin_amdgcn_rcpf(1.0f + __builtin_amdgcn_exp2f(-1.4426950408889634f * g)); }
struct EpiSwiGLU {
    static constexpr bool PERM = true, AFTER_DRAIN = false;
    bf16_t* O; int ldc;
    __device__ __forceinline__ void operator()(const f32x4 (&acc)[2][2][4][2], const Unit& u, int wr, int wc, int fr, int fq) const {
        const int row0 = u.pm * BM + wr * 64 + fr, col0 = u.pn * HALF + wc * 32 + 8 * fq;
#pragma unroll
        for (int ai = 0; ai < 2; ++ai)
#pragma unroll
            for (int m = 0; m < 4; ++m) { bf16_t* rowp = O + (size_t)(row0 + ai * HALF + m * 16) * ldc + col0;
                const f32x4 g0 = acc[ai][0][m][0], g1 = acc[ai][0][m][1], u0 = acc[ai][1][m][0], u1 = acc[ai][1][m][1];
                u32x4 w; w.x = cvt_pk_bf16(silu_f(g0[0]) * u0[0], silu_f(g0[1]) * u0[1]); w.y = cvt_pk_bf16(silu_f(g0[2]) * u0[2], silu_f(g0[3]) * u0[3]);
                w.z = cvt_pk_bf16(silu_f(g1[0]) * u1[0], silu_f(g1[1]) * u1[1]); w.w = cvt_pk_bf16(silu_f(g1[2]) * u1[2], silu_f(g1[3]) * u1[3]);
                *(u32x4*)rowp = w; }
    }
};
struct EpiResid {
    static constexpr bool PERM = false, AFTER_DRAIN = false;
    const float* base; float* out; const float* gate; int gpitch; float coef;
    __device__ __forceinline__ void operator()(const f32x4 (&acc)[2][2][4][2], const Unit& u, int wr, int wc, int fr, int fq) const {
        const int row0 = u.pm * BM + wr * 64 + fr, col0 = u.pn * BM + wc * 32 + 4 * fq;
        const float* gp = gate + (size_t)(u.pm >> 3) * gpitch + col0;
        f32x4 gv[2][2];
#pragma unroll
        for (int bj = 0; bj < 2; ++bj)
#pragma unroll
            for (int n = 0; n < 2; ++n) gv[bj][n] = *(const f32x4*)(gp + bj * HALF + n * 16) * coef;
#pragma unroll
        for (int ai = 0; ai < 2; ++ai)
#pragma unroll
            for (int m = 0; m < 4; ++m) { const size_t off = (size_t)(row0 + ai * HALF + m * 16) * 1024 + col0;
#pragma unroll
                for (int bj = 0; bj < 2; ++bj)
#pragma unroll
                    for (int n = 0; n < 2; ++n) *(f32x4*)(out + off + bj * HALF + n * 16) = *(const f32x4*)(base + off + bj * HALF + n * 16) + gv[bj][n] * acc[ai][bj][m][n]; }
    }
};
struct EpiProj {
    static constexpr bool PERM = true, AFTER_DRAIN = false;
    bf16_t* P; float* WI; const float* rope;
    __device__ __forceinline__ void operator()(const f32x4 (&acc)[2][2][4][2], const Unit& u, int wr, int wc, int fr, int fq) const {
        const int pn = u.pn; const int row0 = u.pm * BM + wr * 64 + fr, col0 = pn * BM + wc * 32 + 8 * fq;
        const bool is_gelu = pn < 4, is_rope_tile = (pn >= 4 && pn < 8) || pn == 10 || pn == 11;
        const bool rope_wave = is_rope_tile && ((wc & 1) == 0);
#pragma unroll
        for (int ai = 0; ai < 2; ++ai)
#pragma unroll
            for (int m = 0; m < 4; ++m) { const int row = row0 + ai * HALF + m * 16; bf16_t* rowp = P + (size_t)row * PROW + col0;
                f32x4 cs0, cs1, sn0, sn1;
                if (rope_wave) { const f32x4* rp = (const f32x4*)(rope + (size_t)row * 16); cs0 = rp[0]; cs1 = rp[1]; sn0 = rp[2]; sn1 = rp[3]; }
#pragma unroll
                for (int bj = 0; bj < 2; ++bj) { f32x4 v0 = acc[ai][bj][m][0], v1 = acc[ai][bj][m][1];
                    if (is_gelu) { f32x2 a = gelu_pk((f32x2){v0[0], v0[1]}), b = gelu_pk((f32x2){v0[2], v0[3]}), c = gelu_pk((f32x2){v1[0], v1[1]}), d = gelu_pk((f32x2){v1[2], v1[3]});
                        v0 = (f32x4){a.x, a.y, b.x, b.y}; v1 = (f32x4){c.x, c.y, d.x, d.y}; }
                    if (rope_wave && (pn != 11 || (bj == 0 && wc == 0))) {
                        f32x4 p0, p1;
#pragma unroll
                        for (int j = 0; j < 4; ++j) { p0[j] = __shfl_xor(v0[j], 16); p1[j] = __shfl_xor(v1[j], 16); }
                        if (fq == 0) { v0 = v0 * cs0 - p0 * sn0; v1 = v1 * cs1 - p1 * sn1; }
                        else if (fq == 1) { v0 = v0 * cs0 + p0 * sn0; v1 = v1 * cs1 + p1 * sn1; }
                    }
                    if (pn == 11 && bj == 0 && wc == 2 && fq == 0) *(f32x4*)(WI + (size_t)row * 4) = v0;
                    u32x4 w; w.x = cvt_pk_bf16(v0[0], v0[1]); w.y = cvt_pk_bf16(v0[2], v0[3]); w.z = cvt_pk_bf16(v1[0], v1[1]); w.w = cvt_pk_bf16(v1[2], v1[3]);
                    *(u32x4*)(rowp + bj * HALF) = w; } }
    }
};
template <class Epi, class Sched, bool ALIGN_EPI = false, bool SP2 = false>
__device__ __forceinline__ void gemm_phase(PG8_LAS unsigned char* lds, const Gemm g, const Sched& S, const Epi& E, const int tid) {
    const int wid = __builtin_amdgcn_readfirstlane(tid >> 6), lane = tid & 63, wr = wid >> 2, wc = wid & 3, fr = lane & 15, fq = lane >> 4;
    const int K = g.K, nt = K / BK;
    unsigned voffA[2], voffB[2];
#pragma unroll
    for (int i = 0; i < 2; ++i) { int R, C; stage_rc(tid * 16 + i * 8192, R, C); const int Rb = Epi::PERM ? ((R & ~31) + perm32(R & 31)) : R;
        voffA[i] = (unsigned)(R * K + C) * 2u; voffB[i] = (unsigned)(Rb * K + C) * 2u; }
    const size_t kstep = (size_t)(BK * 2);
    const size_t hstep = (size_t)HALF * K * 2;
    const size_t tstep = 2 * hstep;
    const unsigned ldsw = (unsigned)wid * 1024u;
    const int aoff = lds_byte(wr * 64 + fr, fq * 8), boff = lds_byte(wc * 32 + fr, fq * 8);
#define PG8_SA(b, h) (((b) * 2 + (h)) * HTB)
#define PG8_SB(b, h) ((4 + (b) * 2 + (h)) * HTB)
#define PG8_STAGE(bufoff, gbase, voff) do { _Pragma("unroll") for (int _i = 0; _i < 2; ++_i) \
        __builtin_amdgcn_global_load_lds((const unsigned*)((const char*)(gbase) + (voff)[_i]), (PG8_LAS unsigned*)(lds + (bufoff) + ldsw + _i * 8192), 16, 0, 0); } while (0)
#define PG8_LDA(dst, b, h) do { _Pragma("unroll") for (int m = 0; m < 4; ++m) _Pragma("unroll") for (int k = 0; k < 2; ++k) dst[m][k] = *(const PG8_LAS bf16x8*)(lds + PG8_SA(b, h) + aoff + m * 2048 + k * 1024); } while (0)
#define PG8_LDB(dst, b, h) do { _Pragma("unroll") for (int n = 0; n < 2; ++n) _Pragma("unroll") for (int k = 0; k < 2; ++k) dst[n][k] = *(const PG8_LAS bf16x8*)(lds + PG8_SB(b, h) + boff + n * 2048 + k * 1024); } while (0)
#define PG8_MMA(ai, bj, At, Bt) do { __builtin_amdgcn_s_setprio(1); _Pragma("unroll") for (int m = 0; m < 4; ++m) _Pragma("unroll") for (int n = 0; n < 2; ++n) _Pragma("unroll") for (int k = 0; k < 2; ++k) \
        acc[ai][bj][m][n] = __builtin_amdgcn_mfma_f32_16x16x32_bf16(Bt[n][k], At[m][k], acc[ai][bj][m][n], 0, 0, 0); __builtin_amdgcn_s_setprio(0); } while (0)
#define PG8_WAIT_V(n) asm volatile("s_waitcnt vmcnt(" #n ")" ::: "memory")
#define PG8_WAIT_L(n) asm volatile("s_waitcnt lgkmcnt(" #n ")" ::: "memory")
#define PG8_BAR __builtin_amdgcn_s_barrier()
#define PG8_SCHED __builtin_amdgcn_sched_barrier(0)
    Unit cur, nxt; int ui = 0;
    if (!S.next(0, cur)) return;
    f32x4 acc[2][2][4][2];
#pragma unroll
    for (int a = 0; a < 2; ++a)
#pragma unroll
        for (int b = 0; b < 2; ++b)
#pragma unroll
            for (int m = 0; m < 4; ++m)
#pragma unroll
                for (int n = 0; n < 2; ++n) acc[a][b][m][n] = (f32x4){0.f, 0.f, 0.f, 0.f};
    bf16x8 At[4][2], B0[2][2], B1[2][2];
    const char* cA = (const char*)g.A + (size_t)cur.pm * tstep; const char* cB = (const char*)g.Bt + (size_t)cur.pn * tstep;
    S.a_ready(cur);
    if constexpr (SP2) {
        PG8_STAGE(PG8_SB(0, 0), cB, voffB); PG8_STAGE(PG8_SB(0, 1), cB + hstep, voffB); PG8_STAGE(PG8_SA(0, 0), cA, voffA); PG8_STAGE(PG8_SA(0, 1), cA + hstep, voffA);
        if (wr == 1) PG8_BAR;
        PG8_WAIT_V(2); PG8_BAR;
        PG8_STAGE(PG8_SB(1, 0), cB + kstep, voffB); PG8_STAGE(PG8_SA(1, 0), cA + kstep, voffA); PG8_STAGE(PG8_SB(1, 1), cB + hstep + kstep, voffB);
        PG8_WAIT_V(6); PG8_BAR;
    } else {
        PG8_STAGE(PG8_SB(0, 0), cB, voffB); PG8_STAGE(PG8_SA(0, 0), cA, voffA); PG8_STAGE(PG8_SB(0, 1), cB + hstep, voffB); PG8_STAGE(PG8_SA(0, 1), cA + hstep, voffA);
        if (wr == 1) PG8_BAR;
        PG8_WAIT_V(4); PG8_BAR;
        PG8_STAGE(PG8_SB(1, 0), cB + kstep, voffB); PG8_STAGE(PG8_SA(1, 0), cA + kstep, voffA); PG8_STAGE(PG8_SB(1, 1), cB + hstep + kstep, voffB);
        PG8_WAIT_V(6); PG8_BAR;
    }
    for (;;) {
        const bool has_next = S.next(ui + 1, nxt);
        const char* nA = has_next ? (const char*)g.A + (size_t)nxt.pm * tstep : cA; const char* nB = has_next ? (const char*)g.Bt + (size_t)nxt.pn * tstep : cB;
        for (int t = 0; t < nt; t += 2) {
            const bool last = (t == nt - 2);
            const char* a1 = cA + (size_t)(t + 1) * kstep;
            const char* a2 = last ? nA : cA + (size_t)(t + 2) * kstep; const char* b2 = last ? nB : cB + (size_t)(t + 2) * kstep;
            const char* a3 = a2 + kstep; const char* b3 = b2 + kstep;
            if (last && has_next) S.a_ready(nxt);
            if constexpr (SP2) {
            PG8_LDB(B0, 0, 0); PG8_LDB(B1, 0, 1); PG8_SCHED; PG8_LDA(At, 0, 0); PG8_STAGE(PG8_SA(1, 1), a1 + hstep, voffA);
            PG8_WAIT_V(8); PG8_WAIT_L(0); PG8_BAR; PG8_MMA(0, 0, At, B0); PG8_MMA(0, 1, At, B1); PG8_BAR; PG8_SCHED;
            PG8_LDA(At, 0, 1); PG8_STAGE(PG8_SB(0, 0), b2, voffB); PG8_STAGE(PG8_SB(0, 1), b2 + hstep, voffB); PG8_STAGE(PG8_SA(0, 0), a2, voffA);
            PG8_WAIT_V(8); PG8_WAIT_L(0); PG8_BAR; PG8_MMA(1, 0, At, B0); PG8_MMA(1, 1, At, B1); PG8_BAR; PG8_SCHED;
            PG8_LDB(B0, 1, 0); PG8_LDB(B1, 1, 1); PG8_SCHED; PG8_LDA(At, 1, 0); PG8_STAGE(PG8_SA(0, 1), a2 + hstep, voffA);
            PG8_WAIT_V(8); PG8_WAIT_L(0); PG8_BAR; PG8_MMA(0, 0, At, B0); PG8_MMA(0, 1, At, B1); PG8_BAR; PG8_SCHED;
            PG8_LDA(At, 1, 1); PG8_STAGE(PG8_SB(1, 0), b3, voffB); PG8_STAGE(PG8_SB(1, 1), b3 + hstep, voffB); PG8_STAGE(PG8_SA(1, 0), a3, voffA);
            PG8_WAIT_V(8); PG8_WAIT_L(0); PG8_BAR; PG8_MMA(1, 0, At, B0); PG8_MMA(1, 1, At, B1); PG8_BAR; PG8_SCHED;
            } else {
            PG8_LDB(B0, 0, 0); PG8_SCHED; PG8_LDA(At, 0, 0); PG8_STAGE(PG8_SA(1, 1), a1 + hstep, voffA);
            PG8_WAIT_L(8); PG8_BAR; PG8_WAIT_L(0); PG8_MMA(0, 0, At, B0); PG8_BAR; PG8_SCHED;
            PG8_LDB(B1, 0, 1); PG8_STAGE(PG8_SB(0, 0), b2, voffB);
            PG8_BAR; PG8_WAIT_L(0); PG8_MMA(0, 1, At, B1); PG8_BAR;
            PG8_LDA(At, 0, 1); PG8_STAGE(PG8_SA(0, 0), a2, voffA);
            PG8_BAR; PG8_WAIT_L(0); PG8_MMA(1, 0, At, B0); PG8_BAR; PG8_SCHED;
            PG8_STAGE(PG8_SB(0, 1), b2 + hstep, voffB);
            PG8_WAIT_V(6); PG8_BAR; PG8_MMA(1, 1, At, B1); PG8_BAR;
            PG8_LDB(B0, 1, 0); PG8_SCHED; PG8_LDA(At, 1, 0); PG8_STAGE(PG8_SA(0, 1), a2 + hstep, voffA);
            PG8_WAIT_L(8); PG8_BAR; PG8_WAIT_L(0); PG8_MMA(0, 0, At, B0); PG8_BAR; PG8_SCHED;
            PG8_LDB(B1, 1, 1); PG8_STAGE(PG8_SB(1, 0), b3, voffB);
            PG8_BAR; PG8_WAIT_L(0); PG8_MMA(0, 1, At, B1); PG8_BAR;
            PG8_LDA(At, 1, 1); PG8_STAGE(PG8_SA(1, 0), a3, voffA);
            PG8_BAR; PG8_WAIT_L(0); PG8_MMA(1, 0, At, B0); PG8_BAR; PG8_SCHED;
            PG8_STAGE(PG8_SB(1, 1), b3 + hstep, voffB);
            PG8_WAIT_V(6); PG8_BAR; PG8_MMA(1, 1, At, B1); PG8_BAR;
            }
        }
        if constexpr (ALIGN_EPI) { if (wr == 0) PG8_BAR; }
        if constexpr (!Epi::AFTER_DRAIN) { E(acc, cur, wr, wc, fr, fq); S.done(cur); }
        if (!has_next) break;
#pragma unroll
        for (int a = 0; a < 2; ++a)
#pragma unroll
            for (int b = 0; b < 2; ++b)
#pragma unroll
                for (int m = 0; m < 4; ++m)
#pragma unroll
                    for (int n = 0; n < 2; ++n) acc[a][b][m][n] = (f32x4){0.f, 0.f, 0.f, 0.f};
        cur = nxt; cA = nA; cB = nB; ++ui;
        if constexpr (ALIGN_EPI) { if (wr == 1) PG8_BAR; }
    }
    PG8_WAIT_V(0);
    if constexpr (!ALIGN_EPI) { if (wr == 0) PG8_BAR; }
    PG8_BAR;
    if constexpr (Epi::AFTER_DRAIN) { E.fused(acc, cur, wr, wc, fr, fq, lds, wid, lane); S.done(cur); }
#undef PG8_SA
#undef PG8_SB
#undef PG8_STAGE
#undef PG8_LDA
#undef PG8_LDB
#undef PG8_MMA
#undef PG8_WAIT_V
#undef PG8_WAIT_L
#undef PG8_BAR
#undef PG8_SCHED
}
}

constexpr int NB = 8, SEQ = 2048, D = 1024, NL = 4, M = NB * SEQ, FF = 2816, FF2 = 2 * FF, PW = 2884, PWP = 3072, NMOD = 9 * D;
constexpr int NWAVES = 8, NTHR = 512;
typedef unsigned short bf16;
typedef unsigned v4u __attribute__((ext_vector_type(4)));
typedef unsigned v2u __attribute__((ext_vector_type(2)));
typedef float f32x4 __attribute__((ext_vector_type(4)));
typedef short bf16x8 __attribute__((ext_vector_type(8)));
typedef short bf16x4 __attribute__((ext_vector_type(4)));
typedef unsigned long long u64;
#define LAS __attribute__((address_space(3)))

constexpr size_t MiB = 1u << 20;
constexpr size_t WS_MOD = 1 * MiB;
constexpr size_t WS_ROPE = 3 * MiB;
constexpr size_t WS_WI = 4 * MiB;
constexpr size_t WS_SGUW = 5 * MiB;
constexpr size_t WS_MASK = 6 * MiB;
constexpr size_t WS_W = 16 * MiB, W_STRIDE = 42 * MiB;
constexpr size_t WO_1IN = 0, WO_1OUT = 11 * MiB, WO_MIX = 17 * MiB, WO_OUT = 23 * MiB, WO_2IN = 25 * MiB, WO_2OUT = 36 * MiB;
constexpr size_t WS_XN = 184 * MiB;
constexpr size_t WS_CAT = 216 * MiB;
constexpr size_t WS_BIG = 248 * MiB;
constexpr size_t WS_END = 344 * MiB;

struct Args {
    const float *x, *c; const int* pos; const float *ada_w, *ada_b, *norm_ffn1, *ffn1_w_in, *ffn1_w_out, *norm_mix, *mix_w_in, *sgu_w, *sgu_b, *mix_w_out, *norm_ffn2, *ffn2_w_in, *ffn2_w_out, *final_norm;
    float* out; unsigned char* ws;
};

__device__ __forceinline__ unsigned f2bf(float f) { unsigned u = __builtin_bit_cast(unsigned, f); return (u + 0x7fffu + ((u >> 16) & 1u)) >> 16; }
__device__ __forceinline__ unsigned pk2(float lo, float hi) { return f2bf(lo) | (f2bf(hi) << 16); }
__device__ __forceinline__ float wave_sum(float v) {
#pragma unroll
    for (int o = 1; o < 64; o <<= 1) v += __shfl_xor(v, o);
    return v;
}

__device__ __forceinline__ void p0_transpose_item(const float* W, int K, int N, bf16* WT, int mode, float* scr, int item, int nblk, int lane) {
    const int kb = item / nblk, nb = item % nblk, k0 = 64 * kb, n0 = 32 * nb;
    const int nsrc = n0 + (lane & 31); const bool ok = nsrc < N;
#pragma unroll 8
    for (int i = 0; i < 32; ++i) { const int kk = 2 * i + (lane >> 5); scr[kk * 33 + (lane & 31)] = ok ? W[(size_t)(k0 + kk) * N + nsrc] : 0.f; }
    asm volatile("s_waitcnt lgkmcnt(0)" ::: "memory");
    int d0 = n0;
    if (mode == 1) { const int j = n0 < FF ? n0 : n0 - FF; d0 = 256 * (j >> 7) + (j & 127) + (n0 < FF ? 0 : 128); }
    const int c = lane & 7;
#pragma unroll
    for (int j = 0; j < 4; ++j) { const int n = (lane >> 3) + 8 * j; const float* s = scr + (8 * c) * 33 + n;
        v4u o; o.x = pk2(s[0 * 33], s[1 * 33]); o.y = pk2(s[2 * 33], s[3 * 33]); o.z = pk2(s[4 * 33], s[5 * 33]); o.w = pk2(s[6 * 33], s[7 * 33]);
        *(v4u*)(WT + (size_t)(d0 + n) * K + k0 + 8 * c) = o; }
    asm volatile("s_waitcnt lgkmcnt(0)" ::: "memory");
}

__device__ __forceinline__ void p0_prologue(const Args& A, unsigned char* lds, int vcu, int G, int tid, int wave, int lane) {
    unsigned char* ws = A.ws;
    float* cact = (float*)lds;
    float* red = (float*)(lds + 32768);
    for (int i = tid; i < NB * D; i += NTHR) { const int b = i / D, k = i % D; const float v = A.c[i]; cact[k * 8 + b] = v / (1.0f + __expf(-v)); }
    __syncthreads();
    float* mod = (float*)(ws + WS_MOD);
    for (int it = vcu; it < NL * (NMOD / 64); it += G) {
        const int l = it / (NMOD / 64), n0 = (it % (NMOD / 64)) * 64;
        const float* wp = A.ada_w + (size_t)l * D * NMOD + (size_t)(128 * wave) * NMOD + n0 + lane;
        float acc[8];
#pragma unroll
        for (int b = 0; b < 8; ++b) acc[b] = 0.f;
#pragma unroll 8
        for (int k = 0; k < 128; ++k) { const float wv = wp[(size_t)k * NMOD]; const f32x4 c0 = *(const f32x4*)(cact + (128 * wave + k) * 8), c1 = *(const f32x4*)(cact + (128 * wave + k) * 8 + 4);
            acc[0] += c0[0] * wv; acc[1] += c0[1] * wv; acc[2] += c0[2] * wv; acc[3] += c0[3] * wv; acc[4] += c1[0] * wv; acc[5] += c1[1] * wv; acc[6] += c1[2] * wv; acc[7] += c1[3] * wv; }
#pragma unroll
        for (int b = 0; b < 8; ++b) red[(wave * 8 + b) * 64 + lane] = acc[b];
        __syncthreads();
        { const int b = tid >> 6, n = tid & 63; float s = A.ada_b[(size_t)l * NMOD + n0 + n];
#pragma unroll
          for (int w = 0; w < 8; ++w) s += red[(w * 8 + b) * 64 + n];
          mod[((size_t)l * NB + b) * NMOD + n0 + n] = s; }
        __syncthreads();
    }
    const int gt = vcu * NTHR + tid, NGT = G * NTHR;
    float* rope = (float*)(ws + WS_ROPE);
    for (int i = gt; i < M * 8; i += NGT) { const int m = i >> 3, f = i & 7; const float inv = exp2f(-(float)f * (0.125f * 18.931568569324174f));
        const float ang = (float)A.pos[m] * inv; const double rev = (double)ang * 0.15915494309189535; const float fr_ = (float)(rev - floor(rev));
        rope[m * 16 + f] = __builtin_amdgcn_cosf(fr_); rope[m * 16 + 8 + f] = __builtin_amdgcn_sinf(fr_); }
    bf16* sw = (bf16*)(ws + WS_SGUW);
    for (int i = gt; i < NL * 4 * 128 * 128; i += NGT) { const int s = i & 127, t = (i >> 7) & 127; sw[i] = (bf16)(s <= t ? f2bf(A.sgu_w[i]) : 0u); }
    float* scr = (float*)(lds + wave * 16384);
    const int gw = vcu * NWAVES + wave, NGW = G * NWAVES;
    constexpr int I_IN = (D / 64) * (FF2 / 32), I_OUT = (FF / 64) * (D / 32), I_MIX = (D / 64) * (PWP / 32), I_MO = (D / 64) * (D / 32);
    constexpr int I_LAYER = 2 * I_IN + 2 * I_OUT + I_MIX + I_MO;
    for (int it = gw; it < NL * I_LAYER; it += NGW) {
        const int l = it / I_LAYER; int r = it % I_LAYER; unsigned char* wl = ws + WS_W + (size_t)l * W_STRIDE;
        if (r < I_IN) { p0_transpose_item(A.ffn1_w_in + (size_t)l * D * FF2, D, FF2, (bf16*)(wl + WO_1IN), 1, scr, r, FF2 / 32, lane); continue; } r -= I_IN;
        if (r < I_IN) { p0_transpose_item(A.ffn2_w_in + (size_t)l * D * FF2, D, FF2, (bf16*)(wl + WO_2IN), 1, scr, r, FF2 / 32, lane); continue; } r -= I_IN;
        if (r < I_OUT) { p0_transpose_item(A.ffn1_w_out + (size_t)l * FF * D, FF, D, (bf16*)(wl + WO_1OUT), 0, scr, r, D / 32, lane); continue; } r -= I_OUT;
        if (r < I_OUT) { p0_transpose_item(A.ffn2_w_out + (size_t)l * FF * D, FF, D, (bf16*)(wl + WO_2OUT), 0, scr, r, D / 32, lane); continue; } r -= I_OUT;
        if (r < I_MIX) { p0_transpose_item(A.mix_w_in + (size_t)l * D * PW, D, PW, (bf16*)(wl + WO_MIX), 0, scr, r, PWP / 32, lane); continue; } r -= I_MIX;
        p0_transpose_item(A.mix_w_out + (size_t)l * D * D, D, D, (bf16*)(wl + WO_OUT), 0, scr, r, D / 32, lane);
    }
}

__device__ __forceinline__ void norm_mod_phase(const float* x, const float* g, const float* shift, const float* scale, bf16* XN, int vcu, int G, int wave, int lane) {
    const int gw = vcu * NWAVES + wave, NGW = G * NWAVES;
    for (int blk = gw; blk < M / 8; blk += NGW) {
        const int m0 = blk * 8, b = m0 / SEQ;
        f32x4 gm[4], sh[4];
#pragma unroll
        for (int j = 0; j < 4; ++j) { const int k = 4 * lane + 256 * j; gm[j] = *(const f32x4*)(g + k) * (*(const f32x4*)(scale + (size_t)b * NMOD + k) + 1.0f); sh[j] = *(const f32x4*)(shift + (size_t)b * NMOD + k); }
        for (int r = 0; r < 8; ++r) {
            const float* xr = x + (size_t)(m0 + r) * D; f32x4 v[4]; float s = 0.f;
#pragma unroll
            for (int j = 0; j < 4; ++j) { v[j] = *(const f32x4*)(xr + 4 * lane + 256 * j); s += (v[j][0] * v[j][0] + v[j][1] * v[j][1]) + (v[j][2] * v[j][2] + v[j][3] * v[j][3]); }
            const float rstd = 1.0f / sqrtf(wave_sum(s) * (1.0f / D) + 1e-6f);
            bf16* orow = XN + (size_t)(m0 + r) * D;
#pragma unroll
            for (int j = 0; j < 4; ++j) { const f32x4 o = v[j] * rstd * gm[j] + sh[j]; v2u w; w.x = pk2(o[0], o[1]); w.y = pk2(o[2], o[3]); *(v2u*)(orow + 4 * lane + 256 * j) = w; }
        }
    }
}
__device__ __forceinline__ void final_norm_phase(float* x, const float* g, int vcu, int G, int wave, int lane) {
    const int gw = vcu * NWAVES + wave, NGW = G * NWAVES;
    f32x4 gm[4];
#pragma unroll
    for (int j = 0; j < 4; ++j) gm[j] = *(const f32x4*)(g + 4 * lane + 256 * j);
    for (int m = gw; m < M; m += NGW) {
        float* xr = x + (size_t)m * D; f32x4 v[4]; float s = 0.f;
#pragma unroll
        for (int j = 0; j < 4; ++j) { v[j] = *(const f32x4*)(xr + 4 * lane + 256 * j); s += (v[j][0] * v[j][0] + v[j][1] * v[j][1]) + (v[j][2] * v[j][2] + v[j][3] * v[j][3]); }
        const float rstd = 1.0f / sqrtf(wave_sum(s) * (1.0f / D) + 1e-6f);
#pragma unroll
        for (int j = 0; j < 4; ++j) *(f32x4*)(xr + 4 * lane + 256 * j) = v[j] * rstd * gm[j];
    }
}

constexpr int SGU_PITCH = 260;
__device__ __forceinline__ void sgu_item(const bf16* P, const bf16* sw  , const float* sb  , bf16* CAT, unsigned char* lds, int item, int tid, int wave, int lane) {
    const int g = item & 3, ch = (item >> 2) & 15, b = item >> 6; const int fr = lane & 15, fq = lane >> 4;
    const size_t tok0 = (size_t)b * SEQ + ch * 128;
    __syncthreads();
#pragma unroll
    for (int i = 0; i < 4; ++i) { const int p = tid + i * NTHR, row = p >> 4, cc = p & 15; const v4u v = *(const v4u*)(P + (tok0 + row) * pg8::PROW + 512 + g * 128 + cc * 8);
        unsigned* d = (unsigned*)(lds + row * SGU_PITCH + cc * 16); d[0] = v.x; d[1] = v.y; d[2] = v.z; d[3] = v.w; }
    __syncthreads();
    bf16x8 yf[4];
#pragma unroll
    for (int ks = 0; ks < 4; ++ks)
#pragma unroll
        for (int j = 0; j < 8; ++j) yf[ks][j] = (short)*(const unsigned short*)(lds + (32 * ks + 8 * fq + j) * SGU_PITCH + (16 * wave + fr) * 2);
    const bf16* wg = sw + (size_t)g * 128 * 128;
#pragma unroll
    for (int tt = 0; tt < 8; ++tt) {
        f32x4 acc = (f32x4){0.f, 0.f, 0.f, 0.f};
#pragma unroll
        for (int ks = 0; ks <= tt / 2; ++ks) { const bf16x8 xf = *(const bf16x8*)(wg + (size_t)(16 * tt + fr) * 128 + 32 * ks + 8 * fq); acc = __builtin_amdgcn_mfma_f32_16x16x32_bf16(xf, yf[ks], acc, 0, 0, 0); }
        const int c = 128 * g + 16 * wave + fr;
#pragma unroll
        for (int ii = 0; ii < 4; ++ii) { const int t = 16 * tt + 4 * fq + ii; const size_t tok = tok0 + t;
            const float uu = __uint_as_float((unsigned)P[tok * pg8::PROW + c] << 16);
            CAT[tok * D + c] = (bf16)f2bf((acc[ii] + sb[g * 128 + t]) * uu); }
    }
}

constexpr int KI_PITCH = 144, KI_TILE = 128 * KI_PITCH;
__device__ __forceinline__ u64 causal_bits(int t, int k) { const int n = t - 64 * k + 1; return n >= 64 ? ~0ull : (n <= 0 ? 0ull : ((1ull << n) - 1ull)); }
__device__ __forceinline__ unsigned grp_sum16(unsigned v) { v += __shfl_xor(v, 1); v += __shfl_xor(v, 2); v += __shfl_xor(v, 4); v += __shfl_xor(v, 8); return v; }
__device__ __forceinline__ void indexer_item(const bf16* P, const float* WI, u64* MASK, unsigned char* lds, int b, int j, int tid, int wave, int lane) {
    const int fr = lane & 15, fq = lane >> 4; const int t_own = 32 * j + 4 * wave + fq; const int nt = j / 4 + 1;
    u64* mrow = MASK + ((size_t)b * SEQ + t_own) * 32;
    if (j < 8) {
        for (int k = fr; k < 2 * nt; k += 16) mrow[k] = causal_bits(t_own, k);
        return;
    }
    const bf16* Pb = P + (size_t)b * SEQ * pg8::PROW;
    bf16x8 xq0, xq1;
    { const bf16* qp = Pb + (size_t)(32 * j + 4 * wave + (fr >> 2)) * pg8::PROW + 2560 + (fr & 3) * 64 + 8 * fq; xq0 = *(const bf16x8*)qp; xq1 = *(const bf16x8*)(qp + 32); }
    const f32x4 wv = *(const f32x4*)(WI + ((size_t)b * SEQ + t_own) * 4);
    unsigned sk[128]; const int rel = t_own - fr;
    const bf16* kisrc = Pb + 2816;
    v4u st0, st1;
    const bf16* kp0 = kisrc + (size_t)(tid >> 3) * pg8::PROW + (tid & 7) * 8; const bf16* kp1 = kisrc + (size_t)((tid + NTHR) >> 3) * pg8::PROW + (tid & 7) * 8;
#define KI_LOAD(tile) do { st0 = *(const v4u*)kp0; st1 = *(const v4u*)kp1; kp0 += 128 * pg8::PROW; kp1 += 128 * pg8::PROW; asm volatile("" : "+v"(kp0), "+v"(kp1)); } while (0)
#define KI_STORE(buf) do { const int p0_ = tid, p1_ = tid + NTHR; *(v4u*)(lds + (buf) * KI_TILE + (p0_ >> 3) * KI_PITCH + (p0_ & 7) * 16) = st0; *(v4u*)(lds + (buf) * KI_TILE + (p1_ >> 3) * KI_PITCH + (p1_ & 7) * 16) = st1; } while (0)
    __syncthreads();
    KI_LOAD(0); KI_STORE(0);
    __syncthreads();
#pragma unroll
    for (int tile = 0; tile < 16; ++tile) {
        {
            if (tile + 1 < 16) KI_LOAD(tile + 1);
            const unsigned char* kb = lds + (tile & 1) * KI_TILE;
#pragma unroll
            for (int nb = 0; nb < 8; ++nb) {
                const bf16x8 y0 = *(const bf16x8*)(kb + (16 * nb + fr) * KI_PITCH + 16 * fq), y1 = *(const bf16x8*)(kb + (16 * nb + fr) * KI_PITCH + 16 * fq + 64);
                f32x4 a = __builtin_amdgcn_mfma_f32_16x16x32_bf16(xq0, y0, (f32x4){0.f, 0.f, 0.f, 0.f}, 0, 0, 0);
                a = __builtin_amdgcn_mfma_f32_16x16x32_bf16(xq1, y1, a, 0, 0, 0);
                float sc = wv[0] * fmaxf(a[0], 0.f) + wv[1] * fmaxf(a[1], 0.f) + wv[2] * fmaxf(a[2], 0.f) + wv[3] * fmaxf(a[3], 0.f);
                sc = (sc == 0.f) ? 0.f : sc;
                const unsigned ub = __float_as_uint(sc); unsigned key = ub ^ ((unsigned)((int)ub >> 31) | 0x80000000u);
                sk[tile * 8 + nb] = (rel >= 128 * tile + 16 * nb) ? key : 0u;
                __builtin_amdgcn_sched_barrier(0);
            }
            if (tile + 1 < 16) KI_STORE((tile + 1) & 1);
            __syncthreads();
        }
    }
#undef KI_LOAD
#undef KI_STORE
    unsigned T = 0u, cntT = 4096u;
    for (int bit = 31; bit >= 0; --bit) {
        const unsigned cand = T | (1u << bit); unsigned c = 0u;
#pragma unroll
        for (int tile = 0; tile < 16; ++tile) if (tile < nt) {
#pragma unroll
            for (int nb = 0; nb < 8; ++nb) c += (sk[tile * 8 + nb] >= cand) ? 1u : 0u; }
        c = grp_sum16(c);
        if (c >= 256u) { T = cand; cntT = c; }
        if (__all(cntT == 256u)) break;
    }
    const bool tie_any = __any(cntT != 256u);
    unsigned need = 0u, running = 0u;
    if (tie_any) { unsigned c = 0u;
#pragma unroll
        for (int tile = 0; tile < 16; ++tile) if (tile < nt) {
#pragma unroll
            for (int nb = 0; nb < 8; ++nb) c += (sk[tile * 8 + nb] > T) ? 1u : 0u; }
        c = grp_sum16(c); need = 256u - c; }
    u64 word = 0ull;
#pragma unroll
    for (int tile = 0; tile < 16; ++tile) if (tile < nt) {
#pragma unroll
        for (int nb = 0; nb < 8; ++nb) { const int r = tile * 8 + nb; const unsigned v = sk[r]; bool sel;
            if (tie_any) { const bool eq = (v == T); const u64 be = __ballot(eq); const unsigned pe = (unsigned)(be >> (16 * fq)) & 0xFFFFu;
                const unsigned before = running + __popc(pe & ((1u << fr) - 1u)); sel = (v > T) || (eq && before < need); running += __popc(pe); }
            else sel = v >= T;
            const u64 bs = __ballot(sel); const unsigned ps = (unsigned)(bs >> (16 * fq)) & 0xFFFFu;
            word |= (u64)ps << (16 * (r & 3));
            if ((r & 3) == 3) { if (fr == 0) mrow[r >> 2] = word; word = 0ull; } } }
}

constexpr int AT_PITCH = 144, AT_TILE = 64 * AT_PITCH;
__device__ __forceinline__ void attn_unit(const bf16* P, const u64* MASK, bf16* CAT, unsigned char* lds, int b, int h, int qb, int tid, int wave, int lane) {
    const int fr = lane & 15, fq = lane >> 4; const int q0 = 128 * qb + 16 * wave;
    const bf16* Pb = P + (size_t)b * SEQ * pg8::PROW;
    bf16x8 qf0, qf1;
    { const bf16* qp = Pb + (size_t)(q0 + fr) * pg8::PROW + 1024 + h * 64 + 8 * fq; qf0 = *(const bf16x8*)qp; qf1 = *(const bf16x8*)(qp + 32); }
    const u64* mrow = MASK + ((size_t)b * SEQ + q0 + fr) * 32;
    f32x4 o[4];
#pragma unroll
    for (int i = 0; i < 4; ++i) o[i] = (f32x4){0.f, 0.f, 0.f, 0.f};
    float mrun = -1e30f, lrun = 0.f;
    const int NT = 2 * (qb + 1);
    const int kkey = tid >> 3, kch = tid & 7, vkey = tid & 63, vch = tid >> 6;
    const bf16* ksrc = Pb + (size_t)kkey * pg8::PROW + 1536 + h * 64 + kch * 8;
    const bf16* vsrc = Pb + (size_t)vkey * pg8::PROW + 2048 + h * 64 + vch * 8;
    v4u kreg, vreg;
#define AT_LOAD(t) do { kreg = *(const v4u*)(ksrc + (size_t)(64 * (t)) * pg8::PROW); vreg = *(const v4u*)(vsrc + (size_t)(64 * (t)) * pg8::PROW); } while (0)
#define AT_STORE(buf) do { *(v4u*)(lds + (buf) * AT_TILE + kkey * AT_PITCH + kch * 16) = kreg; \
        unsigned short* vd_ = (unsigned short*)(lds + (2 + (buf)) * AT_TILE + (vch * 8) * AT_PITCH + vkey * 2); \
        vd_[0] = (unsigned short)vreg.x; vd_[AT_PITCH / 2] = (unsigned short)(vreg.x >> 16); vd_[2 * (AT_PITCH / 2)] = (unsigned short)vreg.y; vd_[3 * (AT_PITCH / 2)] = (unsigned short)(vreg.y >> 16); \
        vd_[4 * (AT_PITCH / 2)] = (unsigned short)vreg.z; vd_[5 * (AT_PITCH / 2)] = (unsigned short)(vreg.z >> 16); vd_[6 * (AT_PITCH / 2)] = (unsigned short)vreg.w; vd_[7 * (AT_PITCH / 2)] = (unsigned short)(vreg.w >> 16); } while (0)
    __syncthreads();
    AT_LOAD(0); AT_STORE(0);
    __syncthreads();
    const float CS = 0.125f * 1.4426950408889634f;
    for (int t = 0; t < (ATT_TRIVIAL ? 0 : NT); ++t) {
        if (t + 1 < NT) AT_LOAD(t + 1);
        const u64 mw = (ATT_IGNORE_MASK ? causal_bits(q0 + fr, t) : mrow[t]) >> (4 * fq);
        const unsigned mlo = (unsigned)mw, mhi = (unsigned)(mw >> 32);
        const unsigned char* kb = lds + (t & 1) * AT_TILE; const unsigned char* vb = lds + (2 + (t & 1)) * AT_TILE;
        f32x4 s[4];
#pragma unroll
        for (int nb = 0; nb < 4; ++nb) {
            const bf16x8 k0 = *(const bf16x8*)(kb + (16 * nb + fr) * AT_PITCH + 16 * fq), k1 = *(const bf16x8*)(kb + (16 * nb + fr) * AT_PITCH + 16 * fq + 64);
            s[nb] = __builtin_amdgcn_mfma_f32_16x16x32_bf16(k0, qf0, (f32x4){0.f, 0.f, 0.f, 0.f}, 0, 0, 0);
            s[nb] = __builtin_amdgcn_mfma_f32_16x16x32_bf16(k1, qf1, s[nb], 0, 0, 0);
        }
        float tmax = -1e30f;
#pragma unroll
        for (int nb = 0; nb < 4; ++nb) { const unsigned mbits = ((nb & 2) ? mhi : mlo) >> (16 * (nb & 1));
#pragma unroll
            for (int ii = 0; ii < 4; ++ii) { const float v = ((mbits >> ii) & 1u) ? s[nb][ii] * CS : -1e30f; s[nb][ii] = v; tmax = fmaxf(tmax, v); } }
        tmax = fmaxf(tmax, __shfl_xor(tmax, 16)); tmax = fmaxf(tmax, __shfl_xor(tmax, 32));
        const float mnew = fmaxf(mrun, tmax), alpha = __builtin_amdgcn_exp2f(mrun - mnew); mrun = mnew;
        float psum = 0.f;
#pragma unroll
        for (int nb = 0; nb < 4; ++nb)
#pragma unroll
            for (int ii = 0; ii < 4; ++ii) { const float p = __builtin_amdgcn_exp2f(s[nb][ii] - mnew); s[nb][ii] = p; psum += p; }
        lrun = lrun * alpha + psum;
#pragma unroll
        for (int i = 0; i < 4; ++i) o[i] = o[i] * alpha;
        bf16x8 pk[2];
#pragma unroll
        for (int ss = 0; ss < 2; ++ss) { v4u w; w.x = pg8::cvt_pk_bf16(s[2 * ss][0], s[2 * ss][1]); w.y = pg8::cvt_pk_bf16(s[2 * ss][2], s[2 * ss][3]); w.z = pg8::cvt_pk_bf16(s[2 * ss + 1][0], s[2 * ss + 1][1]); w.w = pg8::cvt_pk_bf16(s[2 * ss + 1][2], s[2 * ss + 1][3]);
            pk[ss] = __builtin_bit_cast(bf16x8, w); }
#pragma unroll
        for (int db = 0; db < 4; ++db)
#pragma unroll
            for (int ss = 0; ss < 2; ++ss) { const unsigned char* vp = vb + (16 * db + fr) * AT_PITCH + (32 * ss + 4 * fq) * 2;
                const v2u a0 = *(const v2u*)vp, a1 = *(const v2u*)(vp + 32); v4u aw; aw.x = a0.x; aw.y = a0.y; aw.z = a1.x; aw.w = a1.y;
                o[db] = __builtin_amdgcn_mfma_f32_16x16x32_bf16(__builtin_bit_cast(bf16x8, aw), pk[ss], o[db], 0, 0, 0); }
        if (t + 1 < NT) AT_STORE((t + 1) & 1);
        __syncthreads();
    }
#undef AT_LOAD
#undef AT_STORE
    lrun += __shfl_xor(lrun, 16); lrun += __shfl_xor(lrun, 32);
    const float inv = ATT_TRIVIAL ? 1.0f : 1.0f / lrun; if (ATT_TRIVIAL) { for (int i = 0; i < 4; ++i) o[i] = (f32x4){0.01f * fr, 0.02f * fq, 0.001f * (float)qf0[0], 0.5f}; }
    bf16* orow = CAT + ((size_t)b * SEQ + q0 + fr) * D + 512 + h * 64 + 4 * fq;
#pragma unroll
    for (int db = 0; db < 4; ++db) { v2u w; w.x = pg8::cvt_pk_bf16(o[db][0] * inv, o[db][1] * inv); w.y = pg8::cvt_pk_bf16(o[db][2] * inv, o[db][3] * inv); *(v2u*)(orow + 16 * db) = w; }
}


typedef unsigned v4u_xb __attribute__((ext_vector_type(4)));
#define XB_TMO      128
#define XB_XCNT(j)  (256  + 64 * (j))
#define XB_XSUB(j)  (1280 + 64 * (j))
#define XB_XGEN(j)  (2304 + 64 * (j))
#define XB_TOP      3328
#define XB_TOPGEN   3392
#define XCD_BAR_WORDS 3456
#define XB_SPIN_CAP (1u << 18)

__device__ __forceinline__ unsigned xb_ld(unsigned* p)              { return __hip_atomic_load(p, __ATOMIC_RELAXED, __HIP_MEMORY_SCOPE_AGENT); }
__device__ __forceinline__ unsigned xb_add(unsigned* p, unsigned v) { return __hip_atomic_fetch_add(p, v, __ATOMIC_RELAXED, __HIP_MEMORY_SCOPE_AGENT); }
__device__ __forceinline__ unsigned xb_xcc_id() { return (unsigned)__builtin_amdgcn_s_getreg((3 << 11) | 20) & 0xFu; }
#define XB_SPIN(cond, bar) do { unsigned _sp = 0; while (cond) { __builtin_amdgcn_s_sleep(1); \
    if ((++_sp & 255u) == 0u) { if (xb_ld(&(bar)[XB_TMO])) break; if (_sp > XB_SPIN_CAP) { atomicAdd(&(bar)[XB_TMO], 1u); break; } } } } while (0)

struct XcdBarrier {
    unsigned* bar; unsigned x;
    volatile LAS unsigned* st;
};

__device__ __forceinline__ XcdBarrier xcd_barrier_post(unsigned* bar, volatile LAS unsigned* st) {
    XcdBarrier b; b.bar = bar; b.x = xb_xcc_id(); b.st = st;
    if (threadIdx.x == 0) (void)xb_add(&bar[XB_XCNT(b.x)], 1u);
    return b;
}
__device__ __forceinline__ void xcd_barrier_complete(unsigned* bar, unsigned x, unsigned& nloc, unsigned& nx) {
    const unsigned G = gridDim.x * gridDim.y * gridDim.z;
    unsigned sum, cnt, mine, sp = 0u;
    for (;;) {
        sum = 0u; cnt = 0u; mine = 0u;
#pragma unroll
        for (unsigned j = 0; j < 16; ++j) { const unsigned c = xb_ld(&bar[XB_XCNT(j)]); sum += c; cnt += (c > 0u) ? 1u : 0u; mine = (j == x) ? c : mine; }
        if (sum == G) break;
        __builtin_amdgcn_s_sleep(1);
        if ((++sp & 255u) == 0u) { if (xb_ld(&bar[XB_TMO])) break; if (sp > XB_SPIN_CAP) { atomicAdd(&bar[XB_TMO], 1u); break; } }
    }
    nloc = mine > 0u ? mine : 1u; nx = cnt > 0u ? cnt : 1u;
}

__device__ __forceinline__ void xcd_barrier(const XcdBarrier& b) {
    asm volatile("s_waitcnt vmcnt(0)" ::: "memory");
    __syncthreads();
    if (threadIdx.x == 0) {
        unsigned* bar = b.bar;
        __builtin_amdgcn_s_waitcnt(0);
        unsigned nloc = b.st[0], nx = b.st[1];
        if (nloc == 0u) { xcd_barrier_complete(bar, b.x, nloc, nx); b.st[0] = nloc; b.st[1] = nx; }
        const unsigned old = xb_add(&bar[XB_XSUB(b.x)], 1u);
        const unsigned gen = old / nloc;
        if (old + 1u == (gen + 1u) * nloc) {
            __builtin_amdgcn_fence(__ATOMIC_RELEASE, "agent");
            asm volatile("s_waitcnt vmcnt(0)" ::: "memory");
            const unsigned og = xb_add(&bar[XB_TOP], 1u);
            const unsigned tg = og / nx;
            if (og + 1u == (tg + 1u) * nx) xb_add(&bar[XB_TOPGEN], 1u);
            else XB_SPIN(xb_ld(&bar[XB_TOPGEN]) == tg, bar);
            __builtin_amdgcn_fence(__ATOMIC_ACQUIRE, "agent");
            xb_add(&bar[XB_XGEN(b.x)], 1u);
            asm volatile("s_waitcnt vmcnt(0)" ::: "memory");
        } else {
            XB_SPIN(xb_ld(&bar[XB_XGEN(b.x)]) == gen, bar);
            __builtin_amdgcn_fence(__ATOMIC_ACQUIRE, "agent");
            asm volatile("s_waitcnt vmcnt(0)" ::: "memory");
        }
    }
    __syncthreads();
}

#ifndef PHM
#define PHM 0xFFFF
#endif
constexpr int LDS_BYTES = 147456;
__global__ void __launch_bounds__(NTHR, 2) mega_fwd(Args A) {
    extern __shared__ __attribute__((aligned(16))) unsigned char lds[];
    cg::grid_group grid = cg::this_grid();
#define GSYNC() do { for (int r_ = 0; r_ < R_SYNC; ++r_) { asm volatile("s_waitcnt vmcnt(0) lgkmcnt(0)" ::: "memory"); grid.sync(); __builtin_amdgcn_fence(__ATOMIC_ACQUIRE, "agent"); asm volatile("s_waitcnt vmcnt(0)" ::: "memory"); } } while (0)
    const int tid = threadIdx.x, lane = tid & 63, wave = __builtin_amdgcn_readfirstlane(tid >> 6);
    const int G = gridDim.x, bx = blockIdx.x; const int vcu = (G % 8 == 0) ? (bx % 8) * (G / 8) + bx / 8 : bx;
    unsigned char* ws = A.ws;
    PG8_LAS unsigned char* lds3 = (PG8_LAS unsigned char*)lds;
    float* xres = A.out;
    const float* mod = (const float*)(ws + WS_MOD); const float* rope = (const float*)(ws + WS_ROPE); float* WI = (float*)(ws + WS_WI);
    u64* MASK = (u64*)(ws + WS_MASK); bf16* XN = (bf16*)(ws + WS_XN); bf16* CAT = (bf16*)(ws + WS_CAT); bf16* BIG = (bf16*)(ws + WS_BIG);

    for (int u = tid; u < (LDS_BYTES - 131072) / 4; u += NTHR) ((LAS unsigned*)((LAS unsigned char*)lds + 131072))[u] = 0u;
    __syncthreads();
    XcdBarrier xbar = xcd_barrier_post((unsigned*)ws + 4096, (volatile LAS unsigned*)((LAS unsigned char*)lds + 131072 + 64));
#define XSYNC() do { for (int r_ = 0; r_ < R_SYNC; ++r_) xcd_barrier(xbar); } while (0)
    if (PHM & 1) for (int rr_ = 0; rr_ < R_P0; ++rr_) { p0_prologue(A, lds, vcu, G, tid, wave, lane); __syncthreads(); }
    GSYNC();
    for (int l = 0; l < NL; ++l) {
        int tid_o = tid, lane_o, wave_o;
#define OPQ() do { tid_o = tid; asm volatile("" : "+v"(tid_o)); lane_o = tid_o & 63; wave_o = __builtin_amdgcn_readfirstlane(tid_o >> 6); } while (0)
        OPQ();
        const float* modl = mod + (size_t)l * NB * NMOD; unsigned char* wl = ws + WS_W + (size_t)l * W_STRIDE;
        const float* xin = (l == 0) ? A.x : xres;
        if (PHM & 2) for (int rr_ = 0; rr_ < R_NORM; ++rr_) norm_mod_phase(xin, A.norm_ffn1 + l * D, modl + 0 * D, modl + 1 * D, XN, vcu, G, wave_o, lane_o);
        XSYNC();
        OPQ();
        if (PHM & 4) { pg8::Gemm g{XN, (const bf16*)(wl + WO_1IN), M, FF2, D}; pg8::StaticOrder S; S.init(M, FF2, G, bx); pg8::EpiSwiGLU E{BIG, FF};
          pg8::gemm_phase<pg8::EpiSwiGLU, pg8::StaticOrder, true, true>(lds3, g, S, E, tid_o); }
        XSYNC();
        OPQ();
        if (PHM & 8) { pg8::Gemm g{BIG, (const bf16*)(wl + WO_1OUT), M, D, FF}; pg8::StaticOrder S; S.init(M, D, G, bx); pg8::EpiResid E{xin, xres, modl + 2 * D, NMOD, 0.5f};
          pg8::gemm_phase<pg8::EpiResid, pg8::StaticOrder, true, true>(lds3, g, S, E, tid_o); }
        XSYNC();
        OPQ();
        if (PHM & 2) for (int rr_ = 0; rr_ < R_NORM; ++rr_) norm_mod_phase(xres, A.norm_mix + l * D, modl + 3 * D, modl + 4 * D, XN, vcu, G, wave_o, lane_o);
        XSYNC();
        OPQ();
        if (PHM & 16) { pg8::Gemm g{XN, (const bf16*)(wl + WO_MIX), M, PWP, D}; pg8::StaticOrder S; S.init(M, PWP, G, bx); pg8::EpiProj E{BIG, WI, rope};
          pg8::gemm_phase<pg8::EpiProj, pg8::StaticOrder, true, true>(lds3, g, S, E, tid_o); }
        XSYNC();
        OPQ();
        {
          for (int rr_ = 0; rr_ < R_MIX; ++rr_) {
          if (PHM & 32) for (int it = vcu; it < NB * 32; it += G) { const int b = it >> 5, s = it & 31;
              for (int rep = 0; rep < 2; ++rep) indexer_item(BIG, WI, MASK, lds, b, rep ? 63 - s : s, tid_o, wave_o, lane_o); }
          const bf16* sw = (const bf16*)(ws + WS_SGUW) + (size_t)l * 4 * 128 * 128; const float* sb = A.sgu_b + (size_t)l * 4 * 128;
          if (PHM & 64) for (int it = vcu; it < NB * 16 * 4; it += G) sgu_item(BIG, sw, sb, CAT, lds, it, tid_o, wave_o, lane_o);
          }
        }
        XSYNC();
        OPQ();
        if (PHM & 128) for (int rr_ = 0; rr_ < R_MIX; ++rr_) { for (int it = vcu; it < NB * 8 * 4; it += G) { const int bh = it >> 2, s = it & 3; const int b = bh >> 3, h = bh & 7;
              attn_unit(BIG, MASK, CAT, lds, b, h, 15 - s, tid_o, wave_o, lane_o); attn_unit(BIG, MASK, CAT, lds, b, h, s, tid_o, wave_o, lane_o);
              attn_unit(BIG, MASK, CAT, lds, b, h, 8 + s, tid_o, wave_o, lane_o); attn_unit(BIG, MASK, CAT, lds, b, h, 7 - s, tid_o, wave_o, lane_o); } }
        XSYNC();
        OPQ();
        if (PHM & 256) { pg8::Gemm g{CAT, (const bf16*)(wl + WO_OUT), M, D, D}; pg8::StaticOrder S; S.init(M, D, G, bx); pg8::EpiResid E{xres, xres, modl + 5 * D, NMOD, 1.0f};
          pg8::gemm_phase<pg8::EpiResid, pg8::StaticOrder, true, true>(lds3, g, S, E, tid_o); }
        XSYNC();
        OPQ();
        if (PHM & 2) for (int rr_ = 0; rr_ < R_NORM; ++rr_) norm_mod_phase(xres, A.norm_ffn2 + l * D, modl + 6 * D, modl + 7 * D, XN, vcu, G, wave_o, lane_o);
        XSYNC();
        OPQ();
        if (PHM & 512) { pg8::Gemm g{XN, (const bf16*)(wl + WO_2IN), M, FF2, D}; pg8::StaticOrder S; S.init(M, FF2, G, bx); pg8::EpiSwiGLU E{BIG, FF};
          pg8::gemm_phase<pg8::EpiSwiGLU, pg8::StaticOrder, true, true>(lds3, g, S, E, tid_o); }
        XSYNC();
        OPQ();
        if (PHM & 1024) { pg8::Gemm g{BIG, (const bf16*)(wl + WO_2OUT), M, D, FF}; pg8::StaticOrder S; S.init(M, D, G, bx); pg8::EpiResid E{xres, xres, modl + 8 * D, NMOD, 0.5f};
          pg8::gemm_phase<pg8::EpiResid, pg8::StaticOrder, true, true>(lds3, g, S, E, tid_o); }
        XSYNC();
        OPQ();
    }
    if (PHM & 2048) final_norm_phase(xres, A.final_norm, vcu, G, wave, lane);
}

extern "C" void kernel_launch(void* const* d_in, const int* in_sizes, int n_in, void* d_out, int out_size, void* d_ws, size_t ws_size, hipStream_t stream) {
    static int grid = 0;
    if (grid == 0) {
        if (n_in != 17 || in_sizes[0] != M * D || out_size != M * D || ws_size < WS_END) { fprintf(stderr, "kernel_launch: unexpected shapes/workspace (n_in %d, in0 %d, out %d, ws %zu, need %zu)\n", n_in, n_in > 0 ? in_sizes[0] : -1, out_size, ws_size, (size_t)WS_END); grid = -1; return; }
        int dev = 0, cus = 0, per_cu = 0;
        (void)hipGetDevice(&dev); (void)hipDeviceGetAttribute(&cus, hipDeviceAttributeMultiprocessorCount, dev);
        if (hipFuncSetAttribute((const void*)mega_fwd, hipFuncAttributeMaxDynamicSharedMemorySize, LDS_BYTES) != hipSuccess) { fprintf(stderr, "kernel_launch: hipFuncSetAttribute failed\n"); grid = -1; return; }
        if (hipOccupancyMaxActiveBlocksPerMultiprocessor(&per_cu, (const void*)mega_fwd, NTHR, LDS_BYTES) != hipSuccess || per_cu < 1) { fprintf(stderr, "kernel_launch: occupancy query gave %d\n", per_cu); per_cu = 1; }
        (void)hipGetLastError();
        grid = cus * per_cu;
    }
    if (grid < 0) return;
    if (hipMemsetAsync(d_ws, 0, 65536, stream) != hipSuccess) { fprintf(stderr, "kernel_launch: memset failed\n"); return; }
    Args a{};
    a.x = (const float*)d_in[0]; a.c = (const float*)d_in[1]; a.pos = (const int*)d_in[2]; a.ada_w = (const float*)d_in[3]; a.ada_b = (const float*)d_in[4];
    a.norm_ffn1 = (const float*)d_in[5]; a.ffn1_w_in = (const float*)d_in[6]; a.ffn1_w_out = (const float*)d_in[7]; a.norm_mix = (const float*)d_in[8]; a.mix_w_in = (const float*)d_in[9];
    a.sgu_w = (const float*)d_in[10]; a.sgu_b = (const float*)d_in[11]; a.mix_w_out = (const float*)d_in[12]; a.norm_ffn2 = (const float*)d_in[13]; a.ffn2_w_in = (const float*)d_in[14];
    a.ffn2_w_out = (const float*)d_in[15]; a.final_norm = (const float*)d_in[16]; a.out = (float*)d_out; a.ws = (unsigned char*)d_ws;
    void* args[] = {&a};
    hipError_t e = hipLaunchCooperativeKernel((const void*)mega_fwd, dim3(grid), dim3(NTHR), args, LDS_BYTES, stream);
    if (e != hipSuccess) fprintf(stderr, "kernel_launch: cooperative launch failed: %s (grid %d)\n", hipGetErrorString(e), grid);
}
```
